# Optimizing an MI355X kernel written in HIP

```python
import math
import jax
import jax.numpy as jnp
from jax import lax
import numpy as np

D_MODEL = 2048
BATCH = 4
SEQ = 4096
DEPTH = 4

CTX_LEN = 256
GRID_W = 64

N_BRANCH = 4
BRANCH_W = 512
D_FF = 5632
FFN_RES = 0.5
N_MOD = 9
NORM_EPS = 1e-6

MLA_HEADS = 4
MLA_NOPE = 128
MLA_ROPE = 64
MLA_V = 128
MLA_Q_LORA = 768
MLA_KV_LORA = 512
MLA_SCALE = (MLA_NOPE + MLA_ROPE) ** -0.5
Q_BLOCK = 128
ROPE_BASE = 10000.0

RWKV_HEAD = 64
RWKV_HEADS = BRANCH_W // RWKV_HEAD
RWKV_DECAY_LORA = 64
RWKV_A_LORA = 64
RWKV_G_LORA = 128
RWKV_GN_EPS = 64e-5

S5_GROUP = 16
S5_GROUPS = BRANCH_W // S5_GROUP
S5_STATE = 64

LRU_BLOCKS = 8
LRU_BLOCK = BRANCH_W // LRU_BLOCKS
LRU_CONV = 4
LRU_C = 8.0

MLA_IN = MLA_Q_LORA + MLA_KV_LORA + MLA_ROPE
RWKV_IN = 3 * BRANCH_W + RWKV_DECAY_LORA + RWKV_A_LORA + RWKV_G_LORA
S5_IN = BRANCH_W
LRU_IN = 2 * BRANCH_W
O_RWKV = MLA_IN
O_S5 = O_RWKV + RWKV_IN
O_LRU = O_S5 + S5_IN
MIX_IN = O_LRU + LRU_IN
N_IN = MIX_IN + N_BRANCH * D_MODEL
RWKV_SPLITS = [BRANCH_W, 2 * BRANCH_W, 3 * BRANCH_W, 3 * BRANCH_W + RWKV_DECAY_LORA,
               3 * BRANCH_W + RWKV_DECAY_LORA + RWKV_A_LORA]

kernel_name = 'hybrid_mla_rwkv7_s5_rglru_dit_block'

F32 = jnp.float32


def _rms(x, w):
    xf = x.astype(F32)
    y = xf * lax.rsqrt(jnp.mean(xf * xf, axis=-1, keepdims=True) + NORM_EPS)
    return (y * w.astype(F32)).astype(x.dtype)


def _swiglu(h, w1, w3, w2):
    return (jax.nn.silu(h @ w1) * (h @ w3)) @ w2


def _ffn_half(s, shift, scale, gate, g_pre, g_post, w1, w3, w2):
    h = _rms(s, g_pre) * (1 + scale) + shift
    return s + FFN_RES * gate * _rms(_swiglu(h, w1, w3, w2), g_post)


def _dirstack(t):
    return jnp.stack([t, jnp.flip(t, 1)], 0)


def _dir_flip(t):
    return jnp.stack([t[0], jnp.flip(t[1], 1)], 0)


def _axial_rope(T):
    rows = T // GRID_W
    row = jnp.repeat(jnp.arange(rows, dtype=F32), GRID_W)
    col = jnp.tile(jnp.arange(GRID_W, dtype=F32), rows)
    n_pair = MLA_ROPE // 4
    inv = ROPE_BASE ** (-jnp.arange(n_pair, dtype=F32) / n_pair)
    ang = jnp.concatenate([row[:, None] * inv, col[:, None] * inv], -1)
    return jnp.cos(ang), jnp.sin(ang)


def _rope(x, cos, sin):
    xp = x.astype(F32).reshape(x.shape[:-1] + (-1, 2))
    x1, x2 = xp[..., 0], xp[..., 1]
    out = jnp.stack([x1 * cos - x2 * sin, x1 * sin + x2 * cos], -1)
    return out.reshape(x.shape).astype(x.dtype)


def _mla_project(zm, q_norm, w_uq, kv_norm, w_ukv):
    B, T, _ = zm.shape
    cq = zm[..., :MLA_Q_LORA]
    ckv = zm[..., MLA_Q_LORA:MLA_Q_LORA + MLA_KV_LORA]
    kr = zm[..., MLA_Q_LORA + MLA_KV_LORA:]
    q = (_rms(cq, q_norm) @ w_uq).reshape(B, T, MLA_HEADS, MLA_NOPE + MLA_ROPE)
    kv = (_rms(ckv, kv_norm) @ w_ukv).reshape(B, T, MLA_HEADS, MLA_NOPE + MLA_V)
    return q[..., :MLA_NOPE], q[..., MLA_NOPE:], kv[..., :MLA_NOPE], kr, kv[..., MLA_NOPE:]


def _mla_attend(qn, qr, kn, kr, v):
    s = (jnp.einsum('bqhd,bkhd->bhqk', qn, kn, preferred_element_type=F32)
         + jnp.einsum('bqhr,bkr->bhqk', qr, kr, preferred_element_type=F32)) * MLA_SCALE
    p = jax.nn.softmax(s, axis=-1).astype(v.dtype)
    return jnp.einsum('bhqk,bkhd->bqhd', p, v)


def _mla_mixer(zm, zmc, q_norm, w_uq, kv_norm, w_ukv, cos, sin, with_ctx_out):
    B, T, _ = zm.shape
    qn, qr, kn, kr, v = _mla_project(zm, q_norm, w_uq, kv_norm, w_ukv)
    qr = _rope(qr, cos[:, None], sin[:, None])
    kr = _rope(kr, cos, sin)
    qnc, qrc, knc, krc, vc = _mla_project(zmc, q_norm, w_uq, kv_norm, w_ukv)
    kn_all = jnp.concatenate([kn, knc], 1)
    kr_all = jnp.concatenate([kr, krc], 1)
    v_all = jnp.concatenate([v, vc], 1)
    nb = T // Q_BLOCK

    def blocks(t):
        return jnp.moveaxis(t.reshape((B, nb, Q_BLOCK) + t.shape[2:]), 1, 0)

    o = lax.map(lambda qb: _mla_attend(qb[0], qb[1], kn_all, kr_all, v_all), (blocks(qn), blocks(qr)))
    o = jnp.moveaxis(o, 0, 1).reshape(B, T, MLA_HEADS * MLA_V)
    oc = None
    if with_ctx_out:
        oc = _mla_attend(qnc, qrc, knc, krc, vc).reshape(B, -1, MLA_HEADS * MLA_V)
    return o, oc


def _shift_centred(z, mu_prev, mu_next):
    zp = jnp.pad(z[:, :-1], ((0, 0), (1, 0), (0, 0)))
    zn = jnp.pad(z[:, 1:], ((0, 0), (0, 1), (0, 0)))
    return z + (zp - z) * mu_prev + (zn - z) * mu_next


def _rwkv_inputs(z, mu, w0, w2, a0, a2, g2, k_k, k_a):
    B, T, _ = z.shape
    z = _shift_centred(z, mu[0], mu[1])
    r, k, v, wl, al, gl = jnp.split(z, RWKV_SPLITS, axis=-1)
    r, k, v = r.astype(F32), k.astype(F32), v.astype(F32)
    heads = lambda t: t.reshape(t.shape[:-1] + (RWKV_HEADS, RWKV_HEAD))
    w_pre = (w0[:, None, None, :] + jnp.einsum('btl,dlc->dbtc', jnp.tanh(wl), w2)).astype(F32)
    decay = jnp.exp(-jnp.exp(-jax.nn.softplus(-w_pre) - 0.5))
    a = jax.nn.sigmoid((a0[:, None, None, :] + jnp.einsum('btl,dlc->dbtc', al, a2)).astype(F32))
    kk = heads(k * k_k.astype(F32))
    kk = kk * lax.rsqrt(jnp.sum(kk * kk, -1, keepdims=True) + 1e-12)
    kd = heads(k[None] * (1 + (a - 1) * k_a.astype(F32)))
    g = (jax.nn.sigmoid(gl) @ g2).astype(F32)
    return heads(r), heads(decay), kd, heads(v), kk, heads(a), g


def _rwkv_scan(S0, r, w, k, v, aa, bb):
    def step(S, inp):
        r_t, w_t, k_t, v_t, a_t, b_t = inp
        sa = jnp.einsum('dbhij,dbhj->dbhi', S, a_t)
        S = S * w_t[..., None, :] + sa[..., :, None] * b_t[..., None, :] + v_t[..., :, None] * k_t[..., None, :]
        return S, jnp.einsum('dbhij,dbhj->dbhi', S, r_t)
    xs = tuple(jnp.moveaxis(t, 2, 0) for t in (r, w, k, v, aa, bb))
    S, y = lax.scan(step, S0, xs)
    return S, jnp.moveaxis(y, 0, 2)


def _rwkv_bidir(S0, r, w, kd, v, kk, a):
    S, y = _rwkv_scan(S0, _dirstack(r), _dir_flip(w), _dir_flip(kd), _dirstack(v),
                      -_dirstack(kk), _dir_flip(kk[None] * a))
    return S, y[0] + jnp.flip(y[1], 1)


def _rwkv_out(y, r, kd, v, g, rk, ln_w, ln_b):
    B, T = y.shape[:2]
    mean = jnp.mean(y, -1, keepdims=True)
    var = jnp.mean(jnp.square(y - mean), -1, keepdims=True)
    yn = ((y - mean) * lax.rsqrt(var + RWKV_GN_EPS)).reshape(B, T, BRANCH_W)
    yn = yn * ln_w.astype(F32) + ln_b.astype(F32)
    bonus = jnp.sum(r[None] * kd * rk.astype(F32), -1, keepdims=True) * v[None]
    return (yn + jnp.sum(bonus, 0).reshape(B, T, BRANCH_W)) * g


def _rwkv_mixer(zr, zrc, mu, w0, w2, a0, a2, g2, k_k, k_a, rk, ln_w, ln_b):
    pc = _rwkv_inputs(zrc, mu, w0, w2, a0, a2, g2, k_k, k_a)
    p = _rwkv_inputs(zr, mu, w0, w2, a0, a2, g2, k_k, k_a)
    S0 = jnp.zeros((2, zr.shape[0], RWKV_HEADS, RWKV_HEAD, RWKV_HEAD), F32)
    Sc, yc = _rwkv_bidir(S0, *pc[:6])
    _, y = _rwkv_bidir(Sc, *p[:6])
    out = _rwkv_out(y, p[0], p[2], p[3], p[6], rk, ln_w, ln_b)
    outc = _rwkv_out(yc, pc[0], pc[2], pc[3], pc[6], rk, ln_w, ln_b)
    return out, outc


def _s5_discretise(lam_re, lam_im, log_dt, b_re, b_im):
    lre = jnp.minimum(lam_re.astype(F32), -1e-4)
    lim = lam_im.astype(F32)
    dt = jnp.exp(log_dt.astype(F32))[..., None]
    mag = jnp.exp(lre * dt)
    ar, ai = mag * jnp.cos(lim * dt), mag * jnp.sin(lim * dt)
    den = lre * lre + lim * lim
    nr, ni = ar - 1.0, ai
    cr = (nr * lre + ni * lim) / den
    ci = (ni * lre - nr * lim) / den
    b_re, b_im = b_re.astype(F32), b_im.astype(F32)
    br = cr[..., None] * b_re - ci[..., None] * b_im
    bi = cr[..., None] * b_im + ci[..., None] * b_re
    return ar, ai, br, bi


def _cscan(a_re, a_im, b_re, b_im, h_re, h_im):
    b_re = b_re.at[:, 0].add(a_re * h_re - a_im * h_im)
    b_im = b_im.at[:, 0].add(a_re * h_im + a_im * h_re)
    A_re = jnp.broadcast_to(a_re, b_re.shape)
    A_im = jnp.broadcast_to(a_im, b_im.shape)

    def comb(x, y):
        ar1, ai1, br1, bi1 = x
        ar2, ai2, br2, bi2 = y
        return (ar2 * ar1 - ai2 * ai1, ar2 * ai1 + ai2 * ar1,
                ar2 * br1 - ai2 * bi1 + br2, ar2 * bi1 + ai2 * br1 + bi2)
    _, _, hr, hi = lax.associative_scan(comb, (A_re, A_im, b_re, b_im), axis=1)
    return hr, hi


def _maybe_flip(t, rev):
    return jnp.flip(t, 1) if rev else t


def _s5_mixer(zs, zsc, lam_re, lam_im, log_dt, b_re, b_im, c_re, c_im, d, glu_w, glu_b):
    ar, ai, br, bi = _s5_discretise(lam_re, lam_im, log_dt, b_re, b_im)
    to_groups = lambda t: t.astype(F32).reshape(t.shape[:2] + (S5_GROUPS, S5_GROUP))
    u, uc = to_groups(zs), to_groups(zsc)
    dg = d.astype(F32).reshape(S5_GROUPS, S5_GROUP)
    y, yc = u * dg, uc * dg
    zero = jnp.zeros((zs.shape[0], S5_GROUPS, S5_STATE), F32)
    for di in range(2):
        rev = di == 1
        drive = lambda uu: (jnp.einsum('btgh,gph->btgp', uu, br[di]), jnp.einsum('btgh,gph->btgp', uu, bi[di]))
        read = lambda hr, hi: (jnp.einsum('ghp,btgp->btgh', c_re[di].astype(F32), hr)
                               - jnp.einsum('ghp,btgp->btgh', c_im[di].astype(F32), hi))
        hcr, hci = _cscan(ar[di], ai[di], *drive(_maybe_flip(uc, rev)), zero, zero)
        hr, hi = _cscan(ar[di], ai[di], *drive(_maybe_flip(u, rev)), hcr[:, -1], hci[:, -1])
        yc = yc + _maybe_flip(read(hcr, hci), rev)
        y = y + _maybe_flip(read(hr, hi), rev)

    def glu(t):
        t = jax.nn.gelu(t.reshape(t.shape[:2] + (BRANCH_W,)))
        return t * jax.nn.sigmoid(t @ glu_w.astype(F32) + glu_b.astype(F32))
    return glu(y), glu(yc)


def _conv_centred(x, w, b):
    T = x.shape[1]
    xp = jnp.pad(x, ((0, 0), (2, 1), (0, 0)))
    out = b.astype(F32)
    for j in range(LRU_CONV):
        out = out + xp[:, j:j + T] * w[j].astype(F32)
    return out


def _rscan(a, b, h0):
    b = b.at[:, :, 0].add(a[:, :, 0] * h0)
    _, h = lax.associative_scan(lambda x, y: (x[0] * y[0], y[0] * x[1] + y[1]), (a, b), axis=2)
    return h


def _lru_mixer(zl, zlc, conv_w, conv_b, wa, ba, wx, bx, lam):
    def gates(zz):
        xin, gate = jnp.split(zz.astype(F32), 2, axis=-1)
        xcv = _conv_centred(xin, conv_w, conv_b)
        B, T, _ = xcv.shape
        xb = xcv.reshape(B, T, LRU_BLOCKS, LRU_BLOCK)
        gr = jax.nn.sigmoid(jnp.einsum('btnj,dnjk->dbtnk', xb, wa.astype(F32)).reshape(2, B, T, BRANCH_W)
                            + ba.astype(F32)[:, None, None])
        gi = jax.nn.sigmoid(jnp.einsum('btnj,dnjk->dbtnk', xb, wx.astype(F32)).reshape(2, B, T, BRANCH_W)
                            + bx.astype(F32)[:, None, None])
        log_a = -LRU_C * gr * jax.nn.softplus(-lam.astype(F32))[:, None, None]
        bv = jnp.sqrt(-jnp.expm1(2.0 * log_a)) * gi * xcv[None]
        return _dir_flip(jnp.exp(log_a)), _dir_flip(bv), gate

    ac, bc, gc = gates(zlc)
    a, b, g = gates(zl)
    hc = _rscan(ac, bc, jnp.zeros((2, zl.shape[0], BRANCH_W), F32))
    h = _rscan(a, b, hc[:, :, -1])
    out = (h[0] + jnp.flip(h[1], 1)) * jax.nn.gelu(g)
    outc = (hc[0] + jnp.flip(hc[1], 1)) * jax.nn.gelu(gc)
    return out, outc


def _merge(ys, zg, gate_b, w_branch, w_out):
    out = None
    for k in range(N_BRANCH):
        g = jax.nn.sigmoid(zg[..., k * D_MODEL:(k + 1) * D_MODEL] + gate_b[k])
        term = g * (ys[k].astype(zg.dtype) @ w_branch[k])
        out = term if out is None else out + term
    return out @ w_out


def setup_inputs(seed: int = 0) -> dict:
    key = jax.random.key(seed)
    keys = iter(jax.random.split(key, 64))
    L, D, W, G, P = DEPTH, D_MODEL, BRANCH_W, S5_GROUPS, S5_STATE

    def nrm(shape, scale):
        return scale * jax.random.normal(next(keys), shape, F32)

    def unif(shape, lo, hi):
        return jax.random.uniform(next(keys), shape, F32, lo, hi)

    x = nrm((BATCH, SEQ, D), 1.0)
    c = nrm((BATCH, D), 1.0)
    ctx = nrm((BATCH, CTX_LEN, D), 1.0)
    c_ctx = nrm((D,), 1.0)
    ada_w = nrm((L, D, N_MOD * D), 0.5 * D ** -0.5)
    ada_b = nrm((L, N_MOD * D), 0.01)
    norm_w = 1.0 + nrm((L, 6, D), 0.02)
    ffn_w1 = nrm((L, 2, D, D_FF), D ** -0.5)
    ffn_w3 = nrm((L, 2, D, D_FF), D ** -0.5)
    ffn_w2 = nrm((L, 2, D_FF, D), D_FF ** -0.5)
    w_in = nrm((L, D, N_IN), D ** -0.5)
    gate_b = nrm((L, N_BRANCH, D), 0.01)
    mla_q_norm = 1.0 + nrm((L, MLA_Q_LORA), 0.02)
    mla_w_uq = nrm((L, MLA_Q_LORA, MLA_HEADS * (MLA_NOPE + MLA_ROPE)), MLA_Q_LORA ** -0.5)
    mla_kv_norm = 1.0 + nrm((L, MLA_KV_LORA), 0.02)
    mla_w_ukv = nrm((L, MLA_KV_LORA, MLA_HEADS * (MLA_NOPE + MLA_V)), MLA_KV_LORA ** -0.5)
    rwkv_mu = unif((L, 2, RWKV_IN), 0.0, 0.5)
    rwkv_w0 = jnp.linspace(-6.0, -1.0, W, dtype=F32) + nrm((L, 2, W), 0.1)
    rwkv_w2 = nrm((L, 2, RWKV_DECAY_LORA, W), 0.1 * RWKV_DECAY_LORA ** -0.5)
    rwkv_a0 = nrm((L, 2, W), 0.1)
    rwkv_a2 = nrm((L, 2, RWKV_A_LORA, W), 0.1 * RWKV_A_LORA ** -0.5)
    rwkv_g2 = nrm((L, RWKV_G_LORA, W), RWKV_G_LORA ** -0.5)
    rwkv_kk = 0.85 + nrm((L, W), 0.02)
    rwkv_ka = 1.0 + nrm((L, W), 0.02)
    rwkv_rk = nrm((L, RWKV_HEADS, RWKV_HEAD), 0.1)
    rwkv_ln_w = 1.0 + nrm((L, W), 0.02)
    rwkv_ln_b = nrm((L, W), 0.01)
    s5_lam_re = -0.5 + nrm((L, 2, G, P), 0.01)
    s5_lam_im = math.pi * jnp.arange(P, dtype=F32) + nrm((L, 2, G, P), 0.01)
    s5_log_dt = unif((L, 2, G), math.log(1e-3), math.log(1e-1))
    s5_b_re = nrm((L, 2, G, P, S5_GROUP), (2 * S5_GROUP) ** -0.5)
    s5_b_im = nrm((L, 2, G, P, S5_GROUP), (2 * S5_GROUP) ** -0.5)
    s5_c_re = nrm((L, 2, G, S5_GROUP, P), (2 * P) ** -0.5)
    s5_c_im = nrm((L, 2, G, S5_GROUP, P), (2 * P) ** -0.5)
    s5_d = nrm((L, W), 1.0)
    s5_glu_w = nrm((L, W, W), W ** -0.5)
    s5_glu_b = nrm((L, W), 0.01)
    lru_conv_w = nrm((L, LRU_CONV, W), LRU_CONV ** -0.5)
    lru_conv_b = nrm((L, W), 0.01)
    lru_wa = nrm((L, 2, LRU_BLOCKS, LRU_BLOCK, LRU_BLOCK), LRU_BLOCK ** -0.5)
    lru_ba = nrm((L, 2, W), 0.01)
    lru_wx = nrm((L, 2, LRU_BLOCKS, LRU_BLOCK, LRU_BLOCK), LRU_BLOCK ** -0.5)
    lru_bx = nrm((L, 2, W), 0.01)
    a_target = unif((L, 2, W), 0.9, 0.999) ** (1.0 / LRU_C)
    lru_lam = jnp.log(a_target) - jnp.log1p(-a_target)
    w_branch = nrm((L, N_BRANCH, W, D), W ** -0.5)
    w_out = nrm((L, D, D), D ** -0.5)
    return {'x': x, 'c': c, 'ctx': ctx, 'c_ctx': c_ctx, 'ada_w': ada_w, 'ada_b': ada_b, 'norm_w': norm_w,
            'ffn_w1': ffn_w1, 'ffn_w3': ffn_w3, 'ffn_w2': ffn_w2, 'w_in': w_in, 'gate_b': gate_b,
            'mla_q_norm': mla_q_norm, 'mla_w_uq': mla_w_uq, 'mla_kv_norm': mla_kv_norm, 'mla_w_ukv': mla_w_ukv,
            'rwkv_mu': rwkv_mu, 'rwkv_w0': rwkv_w0, 'rwkv_w2': rwkv_w2, 'rwkv_a0': rwkv_a0, 'rwkv_a2': rwkv_a2,
            'rwkv_g2': rwkv_g2, 'rwkv_kk': rwkv_kk, 'rwkv_ka': rwkv_ka, 'rwkv_rk': rwkv_rk,
            'rwkv_ln_w': rwkv_ln_w, 'rwkv_ln_b': rwkv_ln_b,
            's5_lam_re': s5_lam_re, 's5_lam_im': s5_lam_im, 's5_log_dt': s5_log_dt, 's5_b_re': s5_b_re,
            's5_b_im': s5_b_im, 's5_c_re': s5_c_re, 's5_c_im': s5_c_im, 's5_d': s5_d, 's5_glu_w': s5_glu_w,
            's5_glu_b': s5_glu_b, 'lru_conv_w': lru_conv_w, 'lru_conv_b': lru_conv_b, 'lru_wa': lru_wa,
            'lru_ba': lru_ba, 'lru_wx': lru_wx, 'lru_bx': lru_bx, 'lru_lam': lru_lam,
            'w_branch': w_branch, 'w_out': w_out}


def reference(x, c, ctx, c_ctx, ada_w, ada_b, norm_w, ffn_w1, ffn_w3, ffn_w2, w_in, gate_b,
              mla_q_norm, mla_w_uq, mla_kv_norm, mla_w_ukv,
              rwkv_mu, rwkv_w0, rwkv_w2, rwkv_a0, rwkv_a2, rwkv_g2, rwkv_kk, rwkv_ka, rwkv_rk,
              rwkv_ln_w, rwkv_ln_b,
              s5_lam_re, s5_lam_im, s5_log_dt, s5_b_re, s5_b_im, s5_c_re, s5_c_im, s5_d, s5_glu_w, s5_glu_b,
              lru_conv_w, lru_conv_b, lru_wa, lru_ba, lru_wx, lru_bx, lru_lam,
              w_branch, w_out):
    T = x.shape[1]
    cos, sin = _axial_rope(T)
    xc = ctx
    for l in range(DEPTH):
        ctx_out = l < DEPTH - 1
        mod = (jax.nn.silu(c) @ ada_w[l] + ada_b[l]).reshape(-1, N_MOD, 1, D_MODEL)
        modc = (jax.nn.silu(c_ctx) @ ada_w[l] + ada_b[l]).reshape(1, N_MOD, 1, D_MODEL)
        nw = norm_w[l]

        x = _ffn_half(x, mod[:, 0], mod[:, 1], mod[:, 2], nw[0], nw[1], ffn_w1[l, 0], ffn_w3[l, 0], ffn_w2[l, 0])
        xc = _ffn_half(xc, modc[:, 0], modc[:, 1], modc[:, 2], nw[0], nw[1], ffn_w1[l, 0], ffn_w3[l, 0], ffn_w2[l, 0])

        h = _rms(x, nw[2]) * (1 + mod[:, 4]) + mod[:, 3]
        hc = _rms(xc, nw[2]) * (1 + modc[:, 4]) + modc[:, 3]
        z = h @ w_in[l]
        zc = hc @ (w_in[l] if ctx_out else w_in[l][:, :MIX_IN])

        ya, yac = _mla_mixer(z[..., :O_RWKV], zc[..., :O_RWKV], mla_q_norm[l], mla_w_uq[l],
                             mla_kv_norm[l], mla_w_ukv[l], cos, sin, ctx_out)
        yb, ybc = _rwkv_mixer(z[..., O_RWKV:O_S5], zc[..., O_RWKV:O_S5], rwkv_mu[l], rwkv_w0[l], rwkv_w2[l],
                              rwkv_a0[l], rwkv_a2[l], rwkv_g2[l], rwkv_kk[l], rwkv_ka[l], rwkv_rk[l],
                              rwkv_ln_w[l], rwkv_ln_b[l])
        ys, ysc = _s5_mixer(z[..., O_S5:O_LRU], zc[..., O_S5:O_LRU], s5_lam_re[l], s5_lam_im[l], s5_log_dt[l],
                            s5_b_re[l], s5_b_im[l], s5_c_re[l], s5_c_im[l], s5_d[l], s5_glu_w[l], s5_glu_b[l])
        yd, ydc = _lru_mixer(z[..., O_LRU:MIX_IN], zc[..., O_LRU:MIX_IN], lru_conv_w[l], lru_conv_b[l],
                             lru_wa[l], lru_ba[l], lru_wx[l], lru_bx[l], lru_lam[l])

        m = _merge([ya, yb, ys, yd], z[..., MIX_IN:], gate_b[l], w_branch[l], w_out[l])
        x = x + mod[:, 5] * _rms(m, nw[3])
        x = _ffn_half(x, mod[:, 6], mod[:, 7], mod[:, 8], nw[4], nw[5], ffn_w1[l, 1], ffn_w3[l, 1], ffn_w2[l, 1])

        if ctx_out:
            mc = _merge([yac, ybc, ysc, ydc], zc[..., MIX_IN:], gate_b[l], w_branch[l], w_out[l])
            xc = xc + modc[:, 5] * _rms(mc, nw[3])
            xc = _ffn_half(xc, modc[:, 6], modc[:, 7], modc[:, 8], nw[4], nw[5],
                           ffn_w1[l, 1], ffn_w3[l, 1], ffn_w2[l, 1])
    return x
```

```cpp
#include <hip/hip_runtime.h>
#include <cstdio>
#include <cstdint>

#define LAS __attribute__((address_space(3)))
#define GAS __attribute__((address_space(1)))
typedef unsigned short bf16;
typedef short bf16x8 __attribute__((ext_vector_type(8)));
typedef short s16x4 __attribute__((ext_vector_type(4)));
typedef float f32x2 __attribute__((ext_vector_type(2)));
typedef float f32x4 __attribute__((ext_vector_type(4)));
typedef float f32x16 __attribute__((ext_vector_type(16)));
typedef unsigned u32x2 __attribute__((ext_vector_type(2)));
typedef unsigned u32x4 __attribute__((ext_vector_type(4)));

typedef __bf16 bf16n2 __attribute__((ext_vector_type(2)));
__device__ __forceinline__ unsigned cvt_pk_bf16(float lo, float hi) { const bf16n2 v = __builtin_convertvector((f32x2){lo, hi}, bf16n2); return __builtin_bit_cast(unsigned, v); }
__device__ __forceinline__ float bflo(unsigned w) { return __uint_as_float(w << 16); }
__device__ __forceinline__ float bfhi(unsigned w) { return __uint_as_float(w & 0xffff0000u); }
__device__ __forceinline__ float fast_sigmoid(float x) { return __builtin_amdgcn_rcpf(1.0f + __builtin_amdgcn_exp2f(-1.4426950408889634f * x)); }
__device__ __forceinline__ float gelu_tanh(float x) { const float u = 0.7978845608028654f * (x + 0.044715f * x * x * x); const float e = __builtin_amdgcn_exp2f(-2.8853900817779268f * u); return x * __builtin_amdgcn_rcpf(1.0f + e); }

constexpr unsigned WAVE_TAB_OFF = 131072 + 1024;
__device__ __forceinline__ int hw_tid() {
    const unsigned slot = (unsigned)__builtin_amdgcn_s_getreg((5 << 11) | 4) & 63u;
    const int wave = ((volatile LAS int*)(WAVE_TAB_OFF))[slot];
    int lane_; asm volatile("v_mbcnt_lo_u32_b32 %0, -1, 0\n\tv_mbcnt_hi_u32_b32 %0, -1, %0" : "=v"(lane_));
    return __builtin_amdgcn_readfirstlane(wave) * 64 + lane_;
}
namespace pg8 {
#define PG8_LAS __attribute__((address_space(3)))
typedef unsigned short bf16_t;
constexpr int BM = 256, BK = 64, HALF = 128, HTB = HALF * BK * 2  , STAGE_BYTES = 8 * HTB, NXCD = 8, WGM = 8;

__host__ __device__ __forceinline__ int lds_byte(int r, int c) { const int st = (r >> 4) * 2 + (c >> 5), rr = r & 15, cc = c & 31, ob = rr * 64 + cc * 2; return st * 1024 + (ob ^ (((ob >> 9) & 1) << 5)); }
__host__ __device__ __forceinline__ void stage_rc(int b, int& R, int& C) { const int st = b / 1024, sb = b % 1024, swz = sb ^ (((sb >> 9) & 1) << 5); R = (st >> 1) * 16 + swz / 64; C = (st & 1) * 32 + (swz % 64) / 2; }
__host__ __device__ __forceinline__ int perm32(int rho) { const int n = rho >> 4, i = rho & 15; return 8 * (i >> 2) + 4 * n + (i & 3); }

struct Unit { int pm, pn, z; };
struct Gemm { const bf16_t* A; const bf16_t* Bt; int M, N, K, ld; size_t sA, sB; };

struct StaticOrder {
    int nM, nN, nz, nwg, G, c; bool zs;
    __host__ __device__ void init(int M, int N, int G_, int c_, int nz_ = 1, bool zs_ = false) { nM = M / BM; nN = N / BM; nz = nz_; nwg = nM * nN; G = G_; c = c_; zs = zs_; }
    __host__ __device__ __forceinline__ bool next(int i, Unit& u) const {
        long L;
        if (zs) { const long Lz = (long)i * G + c; if (Lz >= (long)nwg * nz) return false; L = Lz / nz; u.z = (int)(Lz - L * nz); }
        else { const int ti = i / nz; u.z = i - ti * nz; L = (long)ti * G + c; if (L >= nwg) return false; }
        int wgid = (int)L; { const int q = nwg / NXCD, r = nwg % NXCD, xcd = wgid % NXCD, off = wgid / NXCD; wgid = (xcd < r ? xcd * (q + 1) : r * (q + 1) + (xcd - r) * q) + off; }
        const int nig = WGM * nN, gid = wgid / nig, fm = gid * WGM, gsz = (nM - fm) < WGM ? (nM - fm) : WGM;
        u.pm = fm + ((wgid % nig) % gsz); u.pn = (wgid % nig) / gsz; return true;
    }
    __device__ __forceinline__ void a_ready(const Unit&) const {}
    __device__ __forceinline__ void done(const Unit&) const {}
};

struct EpiBf16 {
    static constexpr bool PERM = true, AFTER_DRAIN = false, CHAIN = false;
    bf16_t* O; int ldc; size_t zstride;
    __device__ __forceinline__ void operator()(const f32x4 (&acc)[2][2][4][2], const Unit& u, int wr, int wc, int fr, int fq) const {
        const int row0 = u.pm * BM + wr * 64 + fr; const int col0 = u.pn * BM + wc * 32 + 8 * fq;
#pragma unroll
        for (int ai = 0; ai < 2; ++ai)
#pragma unroll
            for (int m = 0; m < 4; ++m) { bf16_t* rowp = O + (size_t)u.z * zstride + (size_t)(row0 + ai * HALF + m * 16) * ldc + col0;
#pragma unroll
                for (int bj = 0; bj < 2; ++bj) { const f32x4 v0 = acc[ai][bj][m][0], v1 = acc[ai][bj][m][1];
                    u32x4 w; w.x = cvt_pk_bf16(v0[0], v0[1]); w.y = cvt_pk_bf16(v0[2], v0[3]); w.z = cvt_pk_bf16(v1[0], v1[1]); w.w = cvt_pk_bf16(v1[2], v1[3]);
                    *(u32x4*)(rowp + bj * HALF) = w; } }
    }
};
struct EpiSwiGLU {
    static constexpr bool PERM = true, AFTER_DRAIN = false, CHAIN = false;
    bf16_t* O; int ldc;
    __device__ __forceinline__ void operator()(const f32x4 (&acc)[2][2][4][2], const Unit& u, int wr, int wc, int fr, int fq) const {
        const int row0 = u.pm * BM + wr * 64 + fr; const int col0 = u.pn * HALF + wc * 32 + 8 * fq;
#pragma unroll
        for (int ai = 0; ai < 2; ++ai)
#pragma unroll
            for (int m = 0; m < 4; ++m) { bf16_t* rowp = O + (size_t)(row0 + ai * HALF + m * 16) * ldc + col0;
                float o[8];
#pragma unroll
                for (int n = 0; n < 2; ++n)
#pragma unroll
                    for (int j = 0; j < 4; ++j) { const float a = acc[ai][0][m][n][j], b = acc[ai][1][m][n][j]; o[n * 4 + j] = a * fast_sigmoid(a) * b; }
                u32x4 w; w.x = cvt_pk_bf16(o[0], o[1]); w.y = cvt_pk_bf16(o[2], o[3]); w.z = cvt_pk_bf16(o[4], o[5]); w.w = cvt_pk_bf16(o[6], o[7]);
                *(u32x4*)rowp = w; }
    }
};
struct EpiGlu {
    static constexpr bool PERM = true, AFTER_DRAIN = false, CHAIN = false;
    bf16_t* O; const bf16_t* Tin; int ldc; const float* bias;
    __device__ __forceinline__ void operator()(const f32x4 (&acc)[2][2][4][2], const Unit& u, int wr, int wc, int fr, int fq) const {
        const int row0 = u.pm * BM + wr * 64 + fr; const int col0 = u.pn * BM + wc * 32 + 8 * fq;
#pragma unroll
        for (int ai = 0; ai < 2; ++ai)
#pragma unroll
            for (int m = 0; m < 4; ++m) { const size_t ro = (size_t)(row0 + ai * HALF + m * 16) * ldc + col0;
#pragma unroll
                for (int bj = 0; bj < 2; ++bj) { const u32x4 t = *(const u32x4*)(Tin + ro + bj * HALF);
                    const f32x4 b0 = *(const f32x4*)(bias + col0 + bj * HALF), b1 = *(const f32x4*)(bias + col0 + bj * HALF + 4);
                    const f32x4 v0 = acc[ai][bj][m][0] + b0, v1 = acc[ai][bj][m][1] + b1;
                    float o[8];
                    o[0] = bflo(t.x) * fast_sigmoid(v0[0]); o[1] = bfhi(t.x) * fast_sigmoid(v0[1]); o[2] = bflo(t.y) * fast_sigmoid(v0[2]); o[3] = bfhi(t.y) * fast_sigmoid(v0[3]);
                    o[4] = bflo(t.z) * fast_sigmoid(v1[0]); o[5] = bfhi(t.z) * fast_sigmoid(v1[1]); o[6] = bflo(t.w) * fast_sigmoid(v1[2]); o[7] = bfhi(t.w) * fast_sigmoid(v1[3]);
                    u32x4 w; w.x = cvt_pk_bf16(o[0], o[1]); w.y = cvt_pk_bf16(o[2], o[3]); w.z = cvt_pk_bf16(o[4], o[5]); w.w = cvt_pk_bf16(o[6], o[7]);
                    *(u32x4*)(O + ro + bj * HALF) = w; } }
    }
};
struct EpiGate {
    static constexpr bool PERM = true, AFTER_DRAIN = false, CHAIN = false;
    const bf16_t* ZG; int ldz; const float* gate_b; bf16_t* P; bf16_t* MG; int ldc;
    __device__ __forceinline__ void operator()(const f32x4 (&acc)[2][2][4][2], const Unit& u, int wr, int wc, int fr, int fq) const {
        const int row0 = u.pm * BM + wr * 64 + fr; const int col0 = u.pn * BM + wc * 32 + 8 * fq; const int k = u.z;
#pragma unroll
        for (int ai = 0; ai < 2; ++ai)
#pragma unroll
            for (int m = 0; m < 4; ++m) { const int row = row0 + ai * HALF + m * 16;
#pragma unroll
                for (int bj = 0; bj < 2; ++bj) { const int col = col0 + bj * HALF;
                    const u32x4 zg = *(const u32x4*)(ZG + (size_t)row * ldz + k * 2048 + col);
                    const f32x4 g0 = *(const f32x4*)(gate_b + k * 2048 + col), g1 = *(const f32x4*)(gate_b + k * 2048 + col + 4);
                    f32x4 v0, v1;
                    v0[0] = fast_sigmoid(bflo(zg.x) + g0[0]) * acc[ai][bj][m][0][0]; v0[1] = fast_sigmoid(bfhi(zg.x) + g0[1]) * acc[ai][bj][m][0][1];
                    v0[2] = fast_sigmoid(bflo(zg.y) + g0[2]) * acc[ai][bj][m][0][2]; v0[3] = fast_sigmoid(bfhi(zg.y) + g0[3]) * acc[ai][bj][m][0][3];
                    v1[0] = fast_sigmoid(bflo(zg.z) + g1[0]) * acc[ai][bj][m][1][0]; v1[1] = fast_sigmoid(bfhi(zg.z) + g1[1]) * acc[ai][bj][m][1][1];
                    v1[2] = fast_sigmoid(bflo(zg.w) + g1[2]) * acc[ai][bj][m][1][2]; v1[3] = fast_sigmoid(bfhi(zg.w) + g1[3]) * acc[ai][bj][m][1][3];
                    bf16_t* pp = P + (size_t)row * ldc + col;
                    if (k != 0) { const u32x4 pw = *(const u32x4*)pp; v0 += (f32x4){bflo(pw.x), bfhi(pw.x), bflo(pw.y), bfhi(pw.y)}; v1 += (f32x4){bflo(pw.z), bfhi(pw.z), bflo(pw.w), bfhi(pw.w)}; }
                    u32x4 w; w.x = cvt_pk_bf16(v0[0], v0[1]); w.y = cvt_pk_bf16(v0[2], v0[3]); w.z = cvt_pk_bf16(v1[0], v1[1]); w.w = cvt_pk_bf16(v1[2], v1[3]);
                    if (k != 3) *(u32x4*)pp = w; else *(u32x4*)(MG + (size_t)row * ldc + col) = w; } }
    }
};

__device__ __forceinline__ void zero_quad(f32x4& v) { float a, b, c, d; asm volatile("v_mov_b32 %0, 0\n\tv_mov_b32 %1, 0\n\tv_mov_b32 %2, 0\n\tv_mov_b32 %3, 0" : "=v"(a), "=v"(b), "=v"(c), "=v"(d)); v = (f32x4){a, b, c, d}; }
template <class Epi, class Sched, bool ALIGN_EPI = false, bool SP2 = false, int NSEG = 1, int NTS = 0>
__device__ __forceinline__ void gemm_phase(PG8_LAS unsigned char* lds, const Gemm g, const Sched& S, const Epi& E) {
    int tid_ = hw_tid(); asm volatile("" : "+v"(tid_));
    const int tid = tid_, wid = __builtin_amdgcn_readfirstlane(tid >> 6), lane = tid & 63, wr = wid >> 2, wc = wid & 3, fr = lane & 15, fq = lane >> 4;
    const int K = g.K, nt = (NSEG > 1) ? NSEG * NTS : K / BK, ld = g.ld;
    unsigned voffA[2], voffB[2];
#pragma unroll
    for (int i = 0; i < 2; ++i) { int R, C; stage_rc(tid * 16 + i * 8192, R, C); const int Rb = Epi::PERM ? ((R & ~31) + perm32(R & 31)) : R;
        voffA[i] = (unsigned)(R * ld + C) * 2u; voffB[i] = (unsigned)(Rb * ld + C) * 2u; }
    const size_t kstep = (size_t)(BK * 2);
    const size_t hstep = (size_t)HALF * ld * 2;
    const size_t tstep = 2 * hstep;
    const unsigned ldsw = (unsigned)wid * 1024u;
    const int aoff = lds_byte(wr * 64 + fr, fq * 8), boff = lds_byte(wc * 32 + fr, fq * 8);
#define PG8_SA(b, h) (((b) * 2 + (h)) * HTB)
#define PG8_SB(b, h) ((4 + (b) * 2 + (h)) * HTB)
#define PG8_STAGE(bufoff, gbase, voff) do { _Pragma("unroll") for (int _i = 0; _i < 2; ++_i) \
        __builtin_amdgcn_global_load_lds((const unsigned*)((const char*)(gbase) + (voff)[_i]), (PG8_LAS unsigned*)(lds + (bufoff) + ldsw + _i * 8192), 16, 0, 0); } while (0)
#define PG8_LDA(dst, b, h) do { _Pragma("unroll") for (int m = 0; m < 4; ++m) _Pragma("unroll") for (int k = 0; k < 2; ++k) dst[m][k] = *(const PG8_LAS bf16x8*)(lds + PG8_SA(b, h) + aoff + m * 2048 + k * 1024); } while (0)
#define PG8_LDB(dst, b, h) do { _Pragma("unroll") for (int n = 0; n < 2; ++n) _Pragma("unroll") for (int k = 0; k < 2; ++k) dst[n][k] = *(const PG8_LAS bf16x8*)(lds + PG8_SB(b, h) + boff + n * 2048 + k * 1024); } while (0)
#define PG8_MMA(ai, bj, At, Bt) do { __builtin_amdgcn_s_setprio(1); _Pragma("unroll") for (int m = 0; m < 4; ++m) _Pragma("unroll") for (int n = 0; n < 2; ++n) _Pragma("unroll") for (int k = 0; k < 2; ++k) \
        acc[ai][bj][m][n] = __builtin_amdgcn_mfma_f32_16x16x32_bf16(Bt[n][k], At[m][k], acc[ai][bj][m][n], 0, 0, 0); __builtin_amdgcn_s_setprio(0); } while (0)
#define PG8_WAIT_V(n) asm volatile("s_waitcnt vmcnt(" #n ")" ::: "memory")
#define PG8_WAIT_L(n) asm volatile("s_waitcnt lgkmcnt(" #n ")" ::: "memory")
#define PG8_BAR __builtin_amdgcn_s_barrier()
#define PG8_SCHED __builtin_amdgcn_sched_barrier(0)
    Unit cur, nxt; int ui = 0;
    if (!S.next(0, cur)) return;
    f32x4 acc[2][2][4][2];
#pragma unroll
    for (int a = 0; a < 2; ++a)
#pragma unroll
        for (int b = 0; b < 2; ++b)
#pragma unroll
            for (int m = 0; m < 4; ++m)
#pragma unroll
                for (int n = 0; n < 2; ++n) zero_quad(acc[a][b][m][n]);
    bf16x8 At[4][2], B0[2][2], B1[2][2];
    const char* cA = (const char*)g.A + (size_t)cur.z * g.sA + (size_t)cur.pm * tstep; const char* cB = (const char*)g.Bt + (size_t)cur.z * g.sB + (size_t)cur.pn * tstep;
    S.a_ready(cur);
    if constexpr (SP2) {
        PG8_STAGE(PG8_SB(0, 0), cB, voffB); PG8_STAGE(PG8_SB(0, 1), cB + hstep, voffB); PG8_STAGE(PG8_SA(0, 0), cA, voffA); PG8_STAGE(PG8_SA(0, 1), cA + hstep, voffA);
        if (wr == 1) PG8_BAR;
        PG8_WAIT_V(2); PG8_BAR;
        PG8_STAGE(PG8_SB(1, 0), cB + kstep, voffB); PG8_STAGE(PG8_SA(1, 0), cA + kstep, voffA); PG8_STAGE(PG8_SB(1, 1), cB + hstep + kstep, voffB);
        PG8_WAIT_V(6); PG8_BAR;
    } else {
        PG8_STAGE(PG8_SB(0, 0), cB, voffB); PG8_STAGE(PG8_SA(0, 0), cA, voffA); PG8_STAGE(PG8_SB(0, 1), cB + hstep, voffB); PG8_STAGE(PG8_SA(0, 1), cA + hstep, voffA);
        if (wr == 1) PG8_BAR;
        PG8_WAIT_V(4); PG8_BAR;
        PG8_STAGE(PG8_SB(1, 0), cB + kstep, voffB); PG8_STAGE(PG8_SA(1, 0), cA + kstep, voffA); PG8_STAGE(PG8_SB(1, 1), cB + hstep + kstep, voffB);
        PG8_WAIT_V(6); PG8_BAR;
    }
    for (;;) {
        const bool has_next = S.next(ui + 1, nxt);
        const char* nA = has_next ? (const char*)g.A + (size_t)nxt.z * g.sA + (size_t)nxt.pm * tstep : cA; const char* nB = has_next ? (const char*)g.Bt + (size_t)nxt.z * g.sB + (size_t)nxt.pn * tstep : cB;
        for (int t = 0; t < nt; t += 2) {
            const bool last = (t == nt - 2);
            const char* a1; const char* a2; const char* b2;
            if constexpr (NSEG > 1) {
                a1 = cA + (size_t)(t / NTS) * g.sA + (size_t)(t % NTS + 1) * kstep;
                a2 = last ? nA : cA + (size_t)((t + 2) / NTS) * g.sA + (size_t)((t + 2) % NTS) * kstep; b2 = last ? nB : cB + (size_t)((t + 2) / NTS) * g.sB + (size_t)((t + 2) % NTS) * kstep;
            } else {
                a1 = cA + (size_t)(t + 1) * kstep;
                a2 = last ? nA : cA + (size_t)(t + 2) * kstep; b2 = last ? nB : cB + (size_t)(t + 2) * kstep;
            }
            const char* a3 = a2 + kstep; const char* b3 = b2 + kstep;
            if (last && has_next) S.a_ready(nxt);
            if constexpr (SP2) {
            PG8_LDB(B0, 0, 0); PG8_LDB(B1, 0, 1); PG8_SCHED; PG8_LDA(At, 0, 0); PG8_STAGE(PG8_SA(1, 1), a1 + hstep, voffA);
            PG8_WAIT_V(8); PG8_WAIT_L(0); PG8_BAR; PG8_MMA(0, 0, At, B0); PG8_MMA(0, 1, At, B1); PG8_BAR; PG8_SCHED;
            PG8_LDA(At, 0, 1); PG8_STAGE(PG8_SB(0, 0), b2, voffB); PG8_STAGE(PG8_SB(0, 1), b2 + hstep, voffB); PG8_STAGE(PG8_SA(0, 0), a2, voffA);
            PG8_WAIT_V(8); PG8_WAIT_L(0); PG8_BAR; PG8_MMA(1, 0, At, B0); PG8_MMA(1, 1, At, B1); PG8_BAR; PG8_SCHED;
            PG8_LDB(B0, 1, 0); PG8_LDB(B1, 1, 1); PG8_SCHED; PG8_LDA(At, 1, 0); PG8_STAGE(PG8_SA(0, 1), a2 + hstep, voffA);
            PG8_WAIT_V(8); PG8_WAIT_L(0); PG8_BAR; PG8_MMA(0, 0, At, B0); PG8_MMA(0, 1, At, B1); PG8_BAR; PG8_SCHED;
            PG8_LDA(At, 1, 1); PG8_STAGE(PG8_SB(1, 0), b3, voffB); PG8_STAGE(PG8_SB(1, 1), b3 + hstep, voffB); PG8_STAGE(PG8_SA(1, 0), a3, voffA);
            PG8_WAIT_V(8); PG8_WAIT_L(0); PG8_BAR; PG8_MMA(1, 0, At, B0); PG8_MMA(1, 1, At, B1); PG8_BAR; PG8_SCHED;
            } else {
            PG8_LDB(B0, 0, 0); PG8_SCHED; PG8_LDA(At, 0, 0); PG8_STAGE(PG8_SA(1, 1), a1 + hstep, voffA);
            PG8_WAIT_L(8); PG8_BAR; PG8_WAIT_L(0); PG8_MMA(0, 0, At, B0); PG8_BAR; PG8_SCHED;
            PG8_LDB(B1, 0, 1); PG8_STAGE(PG8_SB(0, 0), b2, voffB);
            PG8_BAR; PG8_WAIT_L(0); PG8_MMA(0, 1, At, B1); PG8_BAR;
            PG8_LDA(At, 0, 1); PG8_STAGE(PG8_SA(0, 0), a2, voffA);
            PG8_BAR; PG8_WAIT_L(0); PG8_MMA(1, 0, At, B0); PG8_BAR; PG8_SCHED;
            PG8_STAGE(PG8_SB(0, 1), b2 + hstep, voffB);
            PG8_WAIT_V(6); PG8_BAR; PG8_MMA(1, 1, At, B1); PG8_BAR;
            PG8_LDB(B0, 1, 0); PG8_SCHED; PG8_LDA(At, 1, 0); PG8_STAGE(PG8_SA(0, 1), a2 + hstep, voffA);
            PG8_WAIT_L(8); PG8_BAR; PG8_WAIT_L(0); PG8_MMA(0, 0, At, B0); PG8_BAR; PG8_SCHED;
            PG8_LDB(B1, 1, 1); PG8_STAGE(PG8_SB(1, 0), b3, voffB);
            PG8_BAR; PG8_WAIT_L(0); PG8_MMA(0, 1, At, B1); PG8_BAR;
            PG8_LDA(At, 1, 1); PG8_STAGE(PG8_SA(1, 0), a3, voffA);
            PG8_BAR; PG8_WAIT_L(0); PG8_MMA(1, 0, At, B0); PG8_BAR; PG8_SCHED;
            PG8_STAGE(PG8_SB(1, 1), b3 + hstep, voffB);
            PG8_WAIT_V(6); PG8_BAR; PG8_MMA(1, 1, At, B1); PG8_BAR;
            }
            if constexpr (NSEG > 1) { if (!last && (t + 2) % NTS == 0) { int l3_; asm volatile("v_mbcnt_lo_u32_b32 %0, -1, 0\n\tv_mbcnt_hi_u32_b32 %0, -1, %0" : "=v"(l3_)); E.mid(acc, cur, t / NTS, wr, wc, l3_ & 15, l3_ >> 4); } }
        }
        if constexpr (ALIGN_EPI) { if (wr == 0) PG8_BAR; }
        { int l2_; asm volatile("v_mbcnt_lo_u32_b32 %0, -1, 0\n\tv_mbcnt_hi_u32_b32 %0, -1, %0" : "=v"(l2_)); E(acc, cur, wr, wc, l2_ & 15, l2_ >> 4); }
        S.done(cur);
        if (!has_next) break;
        {
#pragma unroll
        for (int a = 0; a < 2; ++a)
#pragma unroll
            for (int b = 0; b < 2; ++b)
#pragma unroll
                for (int m = 0; m < 4; ++m)
#pragma unroll
                    for (int n = 0; n < 2; ++n) zero_quad(acc[a][b][m][n]);
        }
        cur = nxt; cA = nA; cB = nB; ++ui;
        if constexpr (ALIGN_EPI) { if (wr == 1) PG8_BAR; }
    }
    PG8_WAIT_V(0);
    if constexpr (!ALIGN_EPI) { if (wr == 0) PG8_BAR; }
    PG8_BAR;
#undef PG8_SA
#undef PG8_SB
#undef PG8_STAGE
#undef PG8_LDA
#undef PG8_LDB
#undef PG8_MMA
#undef PG8_WAIT_V
#undef PG8_WAIT_L
#undef PG8_BAR
#undef PG8_SCHED
}
}

namespace att {
constexpr int DQK = 192, DV = 128, KVBLK = 64, QBLK = 32;
constexpr float SCALE = 0.07216878364870322f;
constexpr float THR = 8.f;
constexpr int SHM_V = KVBLK * DV * 2, SHM_K = KVBLK * DQK * 2;
constexpr int ATT_LDS = 2 * SHM_V + 2 * SHM_K + 8 * 64 * 4;
#define KSWZ(row, colB) ((row) * 384 + ((colB) ^ (((row) & 7) << 4)))
#define SBAR() __builtin_amdgcn_sched_barrier(0)
__device__ __forceinline__ int crow(int r, int hi) { return (r & 3) + 8 * (r >> 2) + 4 * hi; }
__device__ __forceinline__ void partialSM(f32x16& p0, f32x16& p1, float& m_reg, float& mn, float& alpha) {
  constexpr float C = SCALE * 1.4426950408889634f;
  float pmax = p0[0];
#pragma unroll
  for (int r = 1; r < 16; ++r) pmax = fmaxf(pmax, p0[r]);
#pragma unroll
  for (int r = 0; r < 16; ++r) pmax = fmaxf(pmax, p1[r]);
  { auto rr = __builtin_amdgcn_permlane32_swap(__float_as_uint(pmax), __float_as_uint(pmax), false, false);
    pmax = fmaxf(__uint_as_float(rr[0]), __uint_as_float(rr[1])); }
  if (__builtin_expect(__all(pmax - m_reg <= THR / SCALE), 1)) { mn = m_reg; alpha = 1.f; }
  else { mn = fmaxf(m_reg, pmax); alpha = __builtin_amdgcn_exp2f((m_reg - mn) * C); m_reg = mn; }
  const float mnC = -mn * C;
#pragma unroll
  for (int r = 0; r < 16; ++r) p0[r] = __builtin_amdgcn_exp2f(fmaf(p0[r], C, mnC));
#pragma unroll
  for (int r = 0; r < 16; ++r) p1[r] = __builtin_amdgcn_exp2f(fmaf(p1[r], C, mnC));
}
__device__ __forceinline__ void finishSM(f32x16& p0, f32x16& p1, float alpha, float& l_reg, bf16x8& pa0, bf16x8& pa1, bf16x8& pa2, bf16x8& pa3) {
  float ps = 0;
#pragma unroll
  for (int r = 0; r < 16; ++r) ps += p0[r];
#pragma unroll
  for (int r = 0; r < 16; ++r) ps += p1[r];
  { auto rr = __builtin_amdgcn_permlane32_swap(__float_as_uint(ps), __float_as_uint(ps), false, false);
    ps = __uint_as_float(rr[0]) + __uint_as_float(rr[1]); }
  l_reg = l_reg * alpha + ps;
#define PK4(P, BASE, OUT) do { unsigned a0 = cvt_pk_bf16(P[BASE + 0], P[BASE + 1]), a1 = cvt_pk_bf16(P[BASE + 2], P[BASE + 3]);   \
    unsigned b0 = cvt_pk_bf16(P[BASE + 4], P[BASE + 5]), b1 = cvt_pk_bf16(P[BASE + 6], P[BASE + 7]);                              \
    auto r0 = __builtin_amdgcn_permlane32_swap(a0, b0, false, false); auto r1 = __builtin_amdgcn_permlane32_swap(a1, b1, false, false); \
    u32x4 w = {r0[0], r1[0], r0[1], r1[1]}; OUT = *reinterpret_cast<bf16x8*>(&w); } while (0)
  PK4(p0, 0, pa0); PK4(p0, 8, pa1); PK4(p1, 0, pa2); PK4(p1, 8, pa3);
#undef PK4
}
__device__ __forceinline__ void qkt(f32x16& p0, f32x16& p1, const char* Ks, const bf16x8* qr, int r32, int hi) {
  p0 = f32x16{}; p1 = f32x16{};
#pragma unroll
  for (int d0 = 0; d0 < 12; ++d0) { const int cb = (d0 * 16 + hi * 8) * 2;
    bf16x8 b0 = *reinterpret_cast<const bf16x8*>(Ks + KSWZ(r32, cb));
    bf16x8 b1 = *reinterpret_cast<const bf16x8*>(Ks + KSWZ(32 + r32, cb));
    p0 = __builtin_amdgcn_mfma_f32_32x32x16_bf16(b0, qr[d0], p0, 0, 0, 0);
    p1 = __builtin_amdgcn_mfma_f32_32x32x16_bf16(b1, qr[d0], p1, 0, 0, 0); }
}
__device__ __forceinline__ int v_st(int k, int c) { const int kk = (k & ~0xC) | ((k & 4) << 1) | ((k & 8) >> 1); return ((kk >> 3) * 4 + (c >> 5)) * 512 + ((kk & 7) * 32 + (c & 31)) * 2; }
__device__ __forceinline__ int v_rd_base(int lane) { return ((lane & 3) << 3) | (((lane >> 2) & 3) << 6) | (((lane >> 4) & 1) << 5) | (((lane >> 5) & 1) << 8); }
constexpr int v_rd_off(int d0, int ks, int half) { return d0 * 512 + ks * 4096 + half * 2048; }
template <int OFF> __device__ __forceinline__ s16x4 tr_read(int vb) {
  s16x4 r; asm volatile("ds_read_b64_tr_b16 %0, %1 offset:%2" : "=&v"(r) : "v"(vb), "i"(OFF) : "memory"); return r;
}
template <int D0> __device__ __forceinline__ void pv_one(f32x16& od, int vb, bf16x8 pa0, bf16x8 pa1, bf16x8 pa2, bf16x8 pa3) {
  const s16x4 l0 = tr_read<v_rd_off(D0, 0, 0)>(vb), h0 = tr_read<v_rd_off(D0, 0, 1)>(vb), l1 = tr_read<v_rd_off(D0, 1, 0)>(vb), h1 = tr_read<v_rd_off(D0, 1, 1)>(vb);
  const s16x4 l2 = tr_read<v_rd_off(D0, 2, 0)>(vb), h2 = tr_read<v_rd_off(D0, 2, 1)>(vb), l3 = tr_read<v_rd_off(D0, 3, 0)>(vb), h3 = tr_read<v_rd_off(D0, 3, 1)>(vb);
  asm volatile("s_waitcnt lgkmcnt(0)" ::: "memory"); SBAR();
#define PK(L, H) (bf16x8){L[0], L[1], L[2], L[3], H[0], H[1], H[2], H[3]}
  od = __builtin_amdgcn_mfma_f32_32x32x16_bf16(pa0, PK(l0, h0), od, 0, 0, 0);
  od = __builtin_amdgcn_mfma_f32_32x32x16_bf16(pa1, PK(l1, h1), od, 0, 0, 0);
  od = __builtin_amdgcn_mfma_f32_32x32x16_bf16(pa2, PK(l2, h2), od, 0, 0, 0);
  od = __builtin_amdgcn_mfma_f32_32x32x16_bf16(pa3, PK(l3, h3), od, 0, 0, 0);
#undef PK
}
__device__ __forceinline__ void attn_unit(const bf16* __restrict__ Qb, const bf16* __restrict__ Kh, const bf16* __restrict__ Vh, bf16* __restrict__ Ob, int ldo, int seq, char* lds) {
  int tid_ = hw_tid(); asm volatile("" : "+v"(tid_));
  const int tid = tid_, wid = tid >> 6, lane = tid & 63, r32 = lane & 31, hi = lane >> 5;
  char* V_lds = lds; char* K_lds = lds + 2 * SHM_V;
  float* ws = (float*)(lds + 2 * SHM_V + 2 * SHM_K) + wid * 64; float* li_l = ws; float* al_l = ws + 32;
  float m_reg = -1e30f, l_reg = 0; f32x16 o[4] = {}; bf16x8 qr[12];
  const bf16* Qw = Qb + (long)(wid * QBLK + r32) * DQK + hi * 8;
#pragma unroll
  for (int d0 = 0; d0 < 12; ++d0) qr[d0] = *reinterpret_cast<const bf16x8*>(Qw + d0 * 16);
  const int sr = tid >> 4, sc = (tid & 15) * 8, vst0 = v_st(sr, sc), vst1 = v_st(32 + sr, sc);
  int kst[3];
#pragma unroll
  for (int i = 0; i < 3; ++i) { const int id = tid + 512 * i; kst[i] = KSWZ(id / 24, (id % 24) * 16); }
  const int vb0 = (int)(uintptr_t)V_lds + v_rd_base(lane);
  bf16x8 vs0, vs1, ks0, ks1, ks2;
#define SLOAD(k0) do { vs0 = *reinterpret_cast<const bf16x8*>(&Vh[(long)((k0) + sr) * DV + sc]); vs1 = *reinterpret_cast<const bf16x8*>(&Vh[(long)((k0) + 32 + sr) * DV + sc]); \
    const bf16* kt_ = Kh + (long)(k0) * DQK; ks0 = *reinterpret_cast<const bf16x8*>(kt_ + (long)tid * 8); ks1 = *reinterpret_cast<const bf16x8*>(kt_ + (long)(tid + 512) * 8); ks2 = *reinterpret_cast<const bf16x8*>(kt_ + (long)(tid + 1024) * 8); } while (0)
#define SWRITE(b) do { *(bf16x8*)(V_lds + (b) * SHM_V + vst0) = vs0; *(bf16x8*)(V_lds + (b) * SHM_V + vst1) = vs1; \
    *(bf16x8*)(K_lds + (b) * SHM_K + kst[0]) = ks0; *(bf16x8*)(K_lds + (b) * SHM_K + kst[1]) = ks1; *(bf16x8*)(K_lds + (b) * SHM_K + kst[2]) = ks2; } while (0)
#define RESC(a) do { if (__any((a) < 1.f)) { if (hi == 0) al_l[r32] = (a); asm volatile("s_waitcnt lgkmcnt(0)" ::: "memory"); \
    _Pragma("unroll") for (int d = 0; d < 4; ++d) _Pragma("unroll") for (int r = 0; r < 16; ++r) o[d][r] *= al_l[crow(r, hi)]; } } while (0)
  f32x16 p0, p1; float mn, al; bf16x8 pa0, pa1, pa2, pa3; const int NT = seq / KVBLK;
  __syncthreads();
  SLOAD(0); asm volatile("s_waitcnt vmcnt(0)" ::: "memory"); SWRITE(0); __syncthreads();
  for (int j = 0; j < NT; ++j) {
    const int b = j & 1;
    if (j + 1 < NT) SLOAD((j + 1) * KVBLK);
    SBAR(); qkt(p0, p1, K_lds + b * SHM_K, qr, r32, hi);
    partialSM(p0, p1, m_reg, mn, al);
    RESC(al);
    finishSM(p0, p1, al, l_reg, pa0, pa1, pa2, pa3); SBAR();
    const int vb = vb0 + b * SHM_V;
    pv_one<0>(o[0], vb, pa0, pa1, pa2, pa3); pv_one<1>(o[1], vb, pa0, pa1, pa2, pa3); pv_one<2>(o[2], vb, pa0, pa1, pa2, pa3); pv_one<3>(o[3], vb, pa0, pa1, pa2, pa3);
    if (j + 1 < NT) { asm volatile("s_waitcnt vmcnt(0)" ::: "memory"); SWRITE(b ^ 1); }
    __syncthreads();
  }
  if (hi == 0) li_l[r32] = l_reg; asm volatile("s_waitcnt lgkmcnt(0)" ::: "memory");
  float rli[16];
#pragma unroll
  for (int r = 0; r < 16; ++r) rli[r] = __builtin_amdgcn_rcpf(li_l[crow(r, hi)]);
  bf16* Ow = Ob + (long)(wid * QBLK) * ldo;
#pragma unroll
  for (int r = 0; r < 16; ++r) { const int orow = crow(r, hi);
#pragma unroll
    for (int d0 = 0; d0 < 4; ++d0) Ow[(long)orow * ldo + d0 * 32 + r32] = (bf16)(cvt_pk_bf16(o[d0][r] * rli[r], 0.f) & 0xffffu); }
#undef SLOAD
#undef SWRITE
#undef RESC
}
}

constexpr int DM = 2048, NBATCH = 4, TL = 4096, NLAYER = 4, TCX = 256, DFF = 5632, BW = 512;
constexpr int M_LAT = NBATCH * TL, M_CTX = NBATCH * TCX, MT = M_LAT + M_CTX;
constexpr int N_IN_W = 12864;
constexpr int NZW = 13056;
constexpr int ZP = 4864;
constexpr int Z_CKV = 768, Z_KR = 1280, Z_RW = 1344, Z_S5 = 3136, Z_LX = 3648, Z_LG = 4160, Z_PAD = 4672, Z_G = 4864;
constexpr int NKEY = TL + TCX;
constexpr int NWAVES = 8;
constexpr float NORM_EPS = 1e-6f;
constexpr int LDS_BYTES = 147456, MISC_OFF = 131072 + 320;

enum { I_X = 0, I_C, I_CTX, I_CCTX, I_ADAW, I_ADAB, I_NORMW, I_W1, I_W3, I_W2, I_WIN, I_GATEB, I_QNORM, I_WUQ, I_KVNORM, I_WUKV,
       I_MU, I_W0, I_RW2, I_A0, I_A2, I_G2, I_KK, I_KA, I_RK, I_LNW, I_LNB, I_LAMRE, I_LAMIM, I_LOGDT, I_BRE, I_BIM, I_CRE, I_CIM, I_S5D, I_GLUW, I_GLUB,
       I_CONVW, I_CONVB, I_WA, I_BA, I_WX, I_BX, I_LAM, I_WBR, I_WOUT, N_INPUTS };

constexpr size_t SZ(size_t rows, size_t cols, size_t b) { return rows * cols * b; }
constexpr size_t WS_CTL = 0, CTL_BYTES = 1u << 20;
constexpr size_t WS_MOD = CTL_BYTES;
constexpr size_t WS_XR = WS_MOD + 1572864;
constexpr size_t WS_H = WS_XR + SZ(MT, DM, 4);
constexpr size_t WS_Y = WS_H + SZ(MT, DM, 2);
constexpr size_t WS_W13 = WS_Y + SZ(MT, DM, 2);
constexpr size_t WS_W2 = WS_W13 + 2 * SZ(11264, 2048, 2);
constexpr size_t WS_WIN = WS_W2 + 2 * SZ(2048, 5632, 2);
constexpr size_t WS_WUQ = WS_WIN + SZ(NZW, 2048, 2);
constexpr size_t WS_WUKV = WS_WUQ + SZ(768, 768, 2);
constexpr size_t WS_WBR = WS_WUKV + SZ(1024, 512, 2);
constexpr size_t WS_WOUT = WS_WBR + 4 * SZ(2048, 512, 2);
constexpr size_t WS_WGLU = WS_WOUT + SZ(2048, 2048, 2);
constexpr size_t WS_WLORA = WS_WGLU + SZ(512, 512, 2);
constexpr size_t WS_WLRU = WS_WLORA + SZ(2560, 256, 2);
constexpr size_t WS_Z = WS_WLRU + SZ(2048, 512, 2);
constexpr size_t WS_GZ = WS_Z + SZ(MT, ZP, 2);
constexpr size_t WS_R1 = WS_GZ + SZ(MT, 8192, 2);
constexpr size_t WS_U = WS_R1;
constexpr size_t WS_PREP = WS_R1;
constexpr size_t WS_CQN = WS_R1;
constexpr size_t WS_CKVN = WS_CQN + SZ(MT, 768, 2);
constexpr size_t WS_LIN = WS_CKVN + SZ(MT, 512, 2);
constexpr size_t WS_XCVB = WS_LIN + SZ(MT, 256, 2);
constexpr size_t WS_RWKB = WS_XCVB + SZ(MT, 512, 2);
constexpr size_t WS_R1E = WS_RWKB + SZ(MT, 512, 2);
constexpr size_t WS_R2 = (WS_R1E - WS_R1 >= SZ(MT, DFF, 2)) ? WS_R1E : WS_R1 + SZ(MT, DFF, 2);
constexpr size_t WS_QB = WS_R2;
constexpr size_t WS_QC = WS_QB + SZ(16 * TL, 192, 2);
constexpr size_t WS_KB = WS_QC + SZ(16 * TCX, 192, 2);
constexpr size_t WS_VB = WS_KB + SZ(16 * NKEY, 192, 2);
constexpr size_t RWS = SZ(MT, BW, 4);
constexpr size_t RWSB = SZ(MT, BW, 2);
constexpr size_t WS_RWW = WS_VB + SZ(16 * NKEY, 128, 2);
constexpr size_t WS_RWB = WS_RWW + 2 * RWS;
constexpr size_t WS_G = WS_RWB + 7 * RWSB;
constexpr size_t WS_PACC = WS_G + RWSB;
constexpr size_t WS_RWY = WS_PACC + SZ(MT, DM, 4);
constexpr size_t WS_LRA = WS_RWY + 2 * RWS;
constexpr size_t WS_LRB = WS_LRA + 2 * RWS;
constexpr size_t WS_S5Y = WS_LRB + 2 * RWS;
constexpr size_t WS_TG = WS_S5Y + 2 * RWS;
constexpr size_t WS_YS = WS_TG + SZ(MT, BW, 2);
constexpr size_t WS_MG = WS_YS + 4 * SZ(MT, BW, 2);
constexpr size_t WS_LRH = WS_MG + SZ(MT, DM, 2);
constexpr size_t WS_YP = WS_LRH + 2 * RWS;
constexpr size_t WS_ROPE = WS_YP + 4 * SZ(M_CTX, DM, 2);
constexpr size_t WS_LRUSP = WS_ROPE + SZ(TL, 64, 4);
constexpr size_t WS_S5D = WS_LRUSP + 4 * 4096;
constexpr size_t WS_NV = WS_S5D + SZ(4 * 2 * 32 * 64, 4, 4);
constexpr size_t WS_WSET2 = WS_NV + SZ(38 * 5, DM, 4);
constexpr size_t WSET_BYTES = WS_Z - WS_W13;
constexpr size_t WS_END = WS_WSET2 + WSET_BYTES;
__device__ __forceinline__ size_t wset_off(int set) { return set ? (WS_WSET2 - WS_W13) : 0; }
constexpr int CW_BAR = 4096, CW_Q = 16384;

#define XB_TMO      128
#define XB_XCNT(j)  (256  + 64 * (j))
#define XB_XSUB(j)  (1280 + 64 * (j))
#define XB_XGEN(j)  (2304 + 64 * (j))
#define XB_TOP      3328
#define XB_TOPGEN   3392
#define XCD_BAR_WORDS 3456
#define XB_SPIN_CAP (1u << 22)
__device__ __forceinline__ unsigned xb_ld(unsigned* p)              { return __hip_atomic_load(p, __ATOMIC_RELAXED, __HIP_MEMORY_SCOPE_AGENT); }
__device__ __forceinline__ unsigned xb_add(unsigned* p, unsigned v) { return __hip_atomic_fetch_add(p, v, __ATOMIC_RELAXED, __HIP_MEMORY_SCOPE_AGENT); }
__device__ __forceinline__ unsigned xb_xcc_id() { return (unsigned)__builtin_amdgcn_s_getreg((3 << 11) | 20) & 0xFu; }
#define XB_SPIN(cond, bar) do { unsigned _sp = 0; while (cond) { __builtin_amdgcn_s_sleep(1); \
    if ((++_sp & 255u) == 0u) { if (xb_ld(&(bar)[XB_TMO])) break; if (_sp > XB_SPIN_CAP) { atomicAdd(&(bar)[XB_TMO], 1u); break; } } } } while (0)
struct XcdBarrier { unsigned* bar; unsigned x; volatile LAS unsigned* st; };
__device__ __forceinline__ XcdBarrier xcd_barrier_post(unsigned* bar, volatile LAS unsigned* st) {
    XcdBarrier b; b.bar = bar; b.x = xb_xcc_id(); b.st = st;
    if (hw_tid() == 0) (void)xb_add(&bar[XB_XCNT(b.x)], 1u);
    return b;
}
__device__ __forceinline__ void xcd_barrier_complete(unsigned* bar, unsigned x, unsigned& nloc, unsigned& nx) {
    const unsigned G = gridDim.x * gridDim.y * gridDim.z;
    unsigned sum, cnt, mine, sp = 0u;
    for (;;) {
        sum = 0u; cnt = 0u; mine = 0u;
#pragma unroll
        for (unsigned j = 0; j < 16; ++j) { const unsigned c = xb_ld(&bar[XB_XCNT(j)]); sum += c; cnt += (c > 0u) ? 1u : 0u; }
        mine = xb_ld(&bar[XB_XCNT(x)]);
        if (sum == G) { mine = xb_ld(&bar[XB_XCNT(x)]); break; }
        __builtin_amdgcn_s_sleep(1);
        if ((++sp & 255u) == 0u) { if (xb_ld(&bar[XB_TMO])) break; if (sp > XB_SPIN_CAP) { atomicAdd(&bar[XB_TMO], 1u); break; } }
    }
    nloc = mine > 0u ? mine : 1u; nx = cnt > 0u ? cnt : 1u;
}
__device__ __forceinline__ void xcd_barrier(const XcdBarrier& b) {
    asm volatile("s_waitcnt vmcnt(0)" ::: "memory");
    __syncthreads();
    if (hw_tid() == 0) {
        unsigned* bar = b.bar; unsigned bx = b.x; asm volatile("" : "+s"(bar), "+s"(bx));
        __builtin_amdgcn_s_waitcnt(0);
        unsigned nloc = b.st[0], nx = b.st[1];
        if (nloc == 0u) { xcd_barrier_complete(bar, bx, nloc, nx); b.st[0] = nloc; b.st[1] = nx; }
        const unsigned old = xb_add(&bar[XB_XSUB(bx)], 1u);
        const unsigned gen = old / nloc;
        if (old + 1u == (gen + 1u) * nloc) {
            __builtin_amdgcn_fence(__ATOMIC_RELEASE, "agent");
            asm volatile("s_waitcnt vmcnt(0)" ::: "memory");
            const unsigned og = xb_add(&bar[XB_TOP], 1u);
            const unsigned tg = og / nx;
            if (og + 1u == (tg + 1u) * nx) xb_add(&bar[XB_TOPGEN], 1u);
            else XB_SPIN(xb_ld(&bar[XB_TOPGEN]) == tg, bar);
            __builtin_amdgcn_fence(__ATOMIC_ACQUIRE, "agent");
            xb_add(&bar[XB_XGEN(bx)], 1u);
            asm volatile("s_waitcnt vmcnt(0)" ::: "memory");
        } else {
            XB_SPIN(xb_ld(&bar[XB_XGEN(bx)]) == gen, bar);
            __builtin_amdgcn_fence(__ATOMIC_ACQUIRE, "agent");
            asm volatile("s_waitcnt vmcnt(0)" ::: "memory");
        }
    }
    __syncthreads();
}

struct KArgs { const float* in[N_INPUTS]; float* out; unsigned char* ws; int ph_lo, ph_hi; };
typedef const __attribute__((address_space(4))) KArgs* KP;
#define LAUNDER_A() KP a = a_in_; asm volatile("" : "+s"(a))
#define LDS_WAIT() asm volatile("s_waitcnt lgkmcnt(0)" ::: "memory")
#define PHASE_IDS() LAUNDER_A(); int tid_ = hw_tid(); asm volatile("" : "+v"(tid_)); int bx_ = blockIdx.x; int gdx_ = gridDim.x; asm volatile("" : "+s"(bx_), "+s"(gdx_)); \
    const int tid = tid_, lane = tid & 63, wave = __builtin_amdgcn_readfirstlane(tid >> 6), gw = bx_ * NWAVES + wave, NGW = gdx_ * NWAVES; (void)tid; (void)lane; (void)wave; (void)gw; (void)NGW
__device__ __forceinline__ float dpp_x(float v, int ctrl) { return 0.f; }
#define DPP_ADD(v, ctrl) v += __builtin_bit_cast(float, __builtin_amdgcn_update_dpp(0, __builtin_bit_cast(int, v), ctrl, 0xF, 0xF, true))
__device__ __forceinline__ float sum8(float v) { DPP_ADD(v, 0xB1); DPP_ADD(v, 0x4E); DPP_ADD(v, 0x141); return v; }
__device__ __forceinline__ float wave_sum(float v) {
    DPP_ADD(v, 0xB1); DPP_ADD(v, 0x4E); DPP_ADD(v, 0x141); DPP_ADD(v, 0x140);
    const int i = __builtin_bit_cast(int, v);
    return (__builtin_bit_cast(float, __builtin_amdgcn_readlane(i, 0)) + __builtin_bit_cast(float, __builtin_amdgcn_readlane(i, 16))) + (__builtin_bit_cast(float, __builtin_amdgcn_readlane(i, 32)) + __builtin_bit_cast(float, __builtin_amdgcn_readlane(i, 48)));
}
__device__ __forceinline__ void ld8bf(const bf16* p, float (&f)[8]) { const u32x4 v = *(const u32x4*)p; f[0] = bflo(v.x); f[1] = bfhi(v.x); f[2] = bflo(v.y); f[3] = bfhi(v.y); f[4] = bflo(v.z); f[5] = bfhi(v.z); f[6] = bflo(v.w); f[7] = bfhi(v.w); }
__device__ __forceinline__ void st8bf(bf16* p, const float (&f)[8]) { u32x4 w; w.x = cvt_pk_bf16(f[0], f[1]); w.y = cvt_pk_bf16(f[2], f[3]); w.z = cvt_pk_bf16(f[4], f[5]); w.w = cvt_pk_bf16(f[6], f[7]); *(u32x4*)p = w; }
__device__ __forceinline__ void ld8f(const float* p, float (&f)[8]) { const f32x4 a = *(const f32x4*)p, b = *(const f32x4*)(p + 4); f[0] = a[0]; f[1] = a[1]; f[2] = a[2]; f[3] = a[3]; f[4] = b[0]; f[5] = b[1]; f[6] = b[2]; f[7] = b[3]; }
__device__ __forceinline__ void st8f(float* p, const float (&f)[8]) { *(f32x4*)p = (f32x4){f[0], f[1], f[2], f[3]}; *(f32x4*)(p + 4) = (f32x4){f[4], f[5], f[6], f[7]}; }
__device__ __forceinline__ int mod_idx(int row) { return row < M_LAT ? (row >> 12) : 4; }
__device__ __forceinline__ const float* modp(KP a, int l, int s, int j) { return (const float*)(a->ws + WS_MOD) + ((size_t)(l * 5 + s) * 9 + j) * DM; }
__device__ __forceinline__ int scan_row(int s, int d, int b) {
    if (s < TCX) { const int t = d ? (TCX - 1 - s) : s; return M_LAT + b * TCX + t; }
    const int u = s - TCX; const int t = d ? (TL - 1 - u) : u; return b * TL + t;
}
constexpr int NSTEP = TCX + TL;

struct TItem { const float* src; bf16* dst; int N, ldt; };
__device__ __forceinline__ void titem_load(const TItem& t, f32x4 (&v)[8], int lane) {
#pragma unroll
    for (int i = 0; i < 8; ++i) v[i] = __builtin_nontemporal_load((const f32x4*)(t.src + (size_t)((lane >> 3) + 8 * i) * t.N + (lane & 7) * 4));
}
__device__ __forceinline__ void titem_to_lds(const f32x4 (&v)[8], LAS float* scr, int lane) {
#pragma unroll
    for (int i = 0; i < 8; ++i) { LAS float* d = scr + ((lane >> 3) + 8 * i) * 33 + (lane & 7) * 4; d[0] = v[i][0]; d[1] = v[i][1]; d[2] = v[i][2]; d[3] = v[i][3]; }
    LDS_WAIT(); asm volatile("" ::: "memory");
}
__device__ __forceinline__ void titem_from_lds(const TItem& t, LAS float* scr, int lane) {
    const int c = lane & 7;
#pragma unroll
    for (int j = 0; j < 4; ++j) { const int n = (lane >> 3) + 8 * j; const LAS float* s = scr + (8 * c) * 33 + n;
        u32x4 o; o.x = cvt_pk_bf16(s[0 * 33], s[1 * 33]); o.y = cvt_pk_bf16(s[2 * 33], s[3 * 33]); o.z = cvt_pk_bf16(s[4 * 33], s[5 * 33]); o.w = cvt_pk_bf16(s[6 * 33], s[7 * 33]);
        __builtin_nontemporal_store(o, (u32x4*)(t.dst + (size_t)n * t.ldt + 8 * c)); }
    LDS_WAIT(); asm volatile("" ::: "memory");
}
constexpr int CV_13 = 32 * 176, CV_2 = 88 * 64, CV_IN = 32 * 402, CV_UQ = 12 * 24, CV_UKV = 8 * 32, CV_BR = 8 * 64, CV_OUT = 32 * 64, CV_GLU = 8 * 16;
constexpr int CV_NITEMS = 4 * CV_13 + 2 * CV_2 + CV_IN + CV_UQ + CV_UKV + 4 * CV_BR + CV_OUT + CV_GLU;
__device__ __forceinline__ void titem_decode(KP a, int l, unsigned char* ws, int it, TItem& t) {
    int r = it; const float* W; bf16* WT; int N, ldt, k0, n0, drow0;
    if (r < 4 * CV_13) { const int mi = r / CV_13; r -= mi * CV_13; const int s = mi >> 1, is3 = mi & 1, kb = r / 176, nb = r % 176; n0 = 32 * nb; k0 = 64 * kb;
        W = a->in[is3 ? I_W3 : I_W1] + (size_t)(l * 2 + s) * DM * DFF; N = DFF; WT = (bf16*)(ws + WS_W13) + (size_t)s * 11264 * 2048; ldt = 2048; drow0 = (n0 >> 7) * 256 + (n0 & 127) + is3 * 128; }
    else if ((r -= 4 * CV_13) < 2 * CV_2) { const int s = r / CV_2; r -= s * CV_2; const int kb = r / 64, nb = r % 64; n0 = 32 * nb; k0 = 64 * kb;
        W = a->in[I_W2] + (size_t)(l * 2 + s) * DFF * DM; N = DM; WT = (bf16*)(ws + WS_W2) + (size_t)s * 2048 * 5632; ldt = 5632; drow0 = n0; }
    else if ((r -= 2 * CV_2) < CV_IN) { const int kb = r / 402, nb = r % 402; n0 = 32 * nb; k0 = 64 * kb;
        W = a->in[I_WIN] + (size_t)l * DM * N_IN_W; N = N_IN_W; WT = (bf16*)(ws + WS_WIN); ldt = 2048; drow0 = n0 < Z_PAD ? n0 : n0 + (Z_G - Z_PAD); }
    else if ((r -= CV_IN) < CV_UQ) { const int kb = r / 24, nb = r % 24; n0 = 32 * nb; k0 = 64 * kb;
        W = a->in[I_WUQ] + (size_t)l * 768 * 768; N = 768; WT = (bf16*)(ws + WS_WUQ); ldt = 768; drow0 = n0; }
    else if ((r -= CV_UQ) < CV_UKV) { const int kb = r / 32, nb = r % 32; n0 = 32 * nb; k0 = 64 * kb;
        W = a->in[I_WUKV] + (size_t)l * 512 * 1024; N = 1024; WT = (bf16*)(ws + WS_WUKV); ldt = 512; drow0 = n0; }
    else if ((r -= CV_UKV) < 4 * CV_BR) { const int k = r / CV_BR; r -= k * CV_BR; const int kb = r / 64, nb = r % 64; n0 = 32 * nb; k0 = 64 * kb;
        W = a->in[I_WBR] + (size_t)(l * 4 + k) * 512 * 2048; N = 2048; WT = (bf16*)(ws + WS_WBR) + (size_t)k * 2048 * 512; ldt = 512; drow0 = n0; }
    else if ((r -= 4 * CV_BR) < CV_OUT) { const int kb = r / 64, nb = r % 64; n0 = 32 * nb; k0 = 64 * kb;
        W = a->in[I_WOUT] + (size_t)l * 2048 * 2048; N = 2048; WT = (bf16*)(ws + WS_WOUT); ldt = 2048; drow0 = n0; }
    else { r -= CV_OUT; const int kb = r / 16, nb = r % 16; n0 = 32 * nb; k0 = 64 * kb;
        W = a->in[I_GLUW] + (size_t)l * 512 * 512; N = 512; WT = (bf16*)(ws + WS_WGLU); ldt = 512; drow0 = n0; }
    t.src = W + (size_t)k0 * N + n0; t.dst = WT + (size_t)drow0 * ldt + k0; t.N = N; t.ldt = ldt;
}
__device__ __forceinline__ void convert_wave(KP a, int l, LAS float* scr, int gw_, int NGW_, int lane) {
#define gw gw_
#define NGW NGW_
    unsigned char* ws = a->ws + wset_off(l & 1);
    if (gw < CV_NITEMS) {
        TItem cur, nxt; f32x4 vc[8], vn[8]; int it = gw;
        titem_decode(a, l, ws, it, cur); titem_load(cur, vc, lane);
        bool h1 = it + NGW < CV_NITEMS; nxt = cur;
#pragma unroll
        for (int i = 0; i < 8; ++i) vn[i] = vc[i];
        if (h1) { titem_decode(a, l, ws, it + NGW, nxt); titem_load(nxt, vn, lane); }
        for (;;) {
            titem_to_lds(vc, scr, lane);
            const int it2 = it + 2 * NGW; const bool h2 = h1 && it2 < CV_NITEMS;
            TItem n2 = nxt;
            if (h2) { titem_decode(a, l, ws, it2, n2); titem_load(n2, vc, lane); }
            titem_from_lds(cur, scr, lane);
            if (!h1) break;
#pragma unroll
            for (int i = 0; i < 8; ++i) { const f32x4 t_ = vn[i]; vn[i] = vc[i]; vc[i] = t_; }
            cur = nxt; nxt = n2; h1 = h2; it += NGW;
        }
    }
    const int gt = gw * 64 + lane, NGT = NGW * 64;
    for (int e = gt; e < (Z_G - Z_PAD) * 256; e += NGT) { unsigned z_ = 0u; asm volatile("" : "+v"(z_)); *(u32x4*)((bf16*)(ws + WS_WIN) + (size_t)Z_PAD * 2048 + (size_t)e * 8) = (u32x4){z_, z_, z_, z_}; }
    for (int e = gt; e < 2560 * 32; e += NGT) {
        const int n = e % 2560, j = e / 2560, k0 = 8 * j, seg = n >> 9, c = n & 511; float f[8];
        const float* src = nullptr;
        if (seg < 2) { if (k0 < 64) src = a->in[I_RW2] + ((size_t)(l * 2 + seg) * 64 + k0) * 512 + c; }
        else if (seg < 4) { if (k0 >= 64 && k0 < 128) src = a->in[I_A2] + ((size_t)(l * 2 + seg - 2) * 64 + (k0 - 64)) * 512 + c; }
        else { if (k0 >= 128) src = a->in[I_G2] + ((size_t)l * 128 + (k0 - 128)) * 512 + c; }
#pragma unroll
        for (int q = 0; q < 8; ++q) f[q] = src ? src[(size_t)q * 512] : 0.f;
        st8bf((bf16*)(ws + WS_WLORA) + (size_t)n * 256 + k0, f);
    }
    for (int e = gt; e < 2048 * 64; e += NGT) {
        const int n = e % 2048, j = e / 2048, k0 = 8 * j, pn = n >> 8, rr = n & 255, isx = rr >> 7, c = (pn & 3) * 128 + (rr & 127), blk = c >> 6, kk = c & 63, d = pn >> 2; float f[8];
        const float* Wsel = a->in[isx ? I_WX : I_WA];
        const bool nz = (k0 >> 6) == blk;
        const float* src = Wsel + ((size_t)((l * 2 + d) * 8 + blk) * 64 + (k0 & 63)) * 64 + kk;
#pragma unroll
        for (int q = 0; q < 8; ++q) f[q] = nz ? src[(size_t)q * 64] : 0.f;
        st8bf((bf16*)(ws + WS_WLRU) + (size_t)n * 512 + k0, f);
    }
#undef gw
#undef NGW
}
__device__ __forceinline__ void convert_weights(KP a_in_, int l, LAS unsigned char* ldsb, int vg, int nvg) {
    PHASE_IDS();
    convert_wave(a, l, (LAS float*)(ldsb + wave * 16384), vg * NWAVES + wave, nvg * NWAVES, lane);
}
__device__ __forceinline__ void tables_phase(KP a_in_) {
    PHASE_IDS();
    unsigned char* ws = a->ws; const int gt = gw * 64 + lane, NGT = NGW * 64;
    for (int e = gt; e < TL * 32; e += NGT) { const int t = e >> 5, i = e & 31; const float inv = powf(10000.0f, -(float)(i & 15) * (1.0f / 16.0f)); const float pos = (float)(i < 16 ? (t >> 6) : (t & 63));
        float sn, co; sincosf(pos * inv, &sn, &co); float* rp = (float*)(ws + WS_ROPE) + (size_t)t * 64; rp[i] = co; rp[32 + i] = sn; }
    for (int e = gt; e < NLAYER * 1024; e += NGT) { const float x = -a->in[I_LAM][e]; ((float*)(ws + WS_LRUSP))[e] = -8.0f * 1.4426950408889634f * (fmaxf(x, 0.f) + log1pf(expf(-fabsf(x)))); }
    for (int e = gt; e < NLAYER * 2 * 32 * 64; e += NGT) { const int gi = e >> 6;
        const float lre = fminf(a->in[I_LAMRE][e], -1e-4f), lim = a->in[I_LAMIM][e], dt = expf(a->in[I_LOGDT][gi]);
        const float mag = expf(lre * dt); float sn, co; sincosf(lim * dt, &sn, &co); const float ar = mag * co, ai = mag * sn;
        const float den = lre * lre + lim * lim, nr = ar - 1.0f, ni = ai;
        *(f32x4*)((float*)(ws + WS_S5D) + (size_t)e * 4) = (f32x4){ar, ai, (nr * lre + ni * lim) / den, (ni * lre - nr * lim) / den}; }
}
__device__ __forceinline__ void mod_phase(KP a_in_, LAS unsigned char* ldsb) {
    PHASE_IDS();
    LAS float* sl = (LAS float*)ldsb;
    LAS float* part = (LAS float*)(ldsb + 40960);
    for (int i = tid; i < 5 * DM; i += 512) { const int s = i / DM, k = i - s * DM; const float c = s < 4 ? a->in[I_C][s * DM + k] : a->in[I_CCTX][k]; sl[i] = c / (1.0f + expf(-c)); }
    __syncthreads();
    for (int u = bx_; u < NLAYER * 72; u += gdx_) {
        const int l = u / 72, cb = u % 72;
        const float* Wp = a->in[I_ADAW] + (size_t)l * DM * 18432 + cb * 256 + 4 * lane;
        f32x4 acc[5];
#pragma unroll
        for (int s = 0; s < 5; ++s) acc[s] = (f32x4){0.f, 0.f, 0.f, 0.f};
        const int kbeg = wave * 256;
#pragma unroll 8
        for (int k = kbeg; k < kbeg + 256; ++k) { const f32x4 w = __builtin_nontemporal_load((const f32x4*)(Wp + (size_t)k * 18432));
#pragma unroll
            for (int s = 0; s < 5; ++s) acc[s] += w * sl[s * DM + k]; }
#pragma unroll
        for (int s = 0; s < 5; ++s) *(LAS f32x4*)(part + (wave * 5 + s) * 256 + 4 * lane) = acc[s];
        __syncthreads();
        for (int o = tid; o < 5 * 256; o += 512) { const int s = o >> 8, c = o & 255; float v = a->in[I_ADAB][(size_t)l * 18432 + cb * 256 + c];
#pragma unroll
            for (int w = 0; w < 8; ++w) v += part[(w * 5 + s) * 256 + c];
            ((float*)(a->ws + WS_MOD))[(size_t)(l * 5 + s) * 18432 + cb * 256 + c] = v; }
        __syncthreads();
    }
}

constexpr int NV_T = 1 + NLAYER * 3;
__device__ __forceinline__ void normvec_phase(KP a_in_) {
    PHASE_IDS();
    float* CG = (float*)(a->ws + WS_NV); float* GV = CG + (size_t)NLAYER * 3 * 5 * DM; float* SH = GV + (size_t)NV_T * 5 * DM;
    const int gt = gw * 64 + lane, NGT = NGW * 64;
    for (int e = gt; e < NLAYER * 3 * 5 * DM; e += NGT) { const int c = e % DM, s = (e / DM) % 5, ls = e / (5 * DM), l = ls / 3, site = ls % 3;
        const float coef = site == 1 ? 1.0f : 0.5f; const int jg = site == 0 ? 2 : (site == 1 ? 5 : 8), nwp = site == 0 ? 1 : (site == 1 ? 3 : 5);
        CG[e] = coef * modp(a, l, s, jg)[c] * a->in[I_NORMW][(size_t)(l * 6 + nwp) * DM + c]; }
    for (int e = gt; e < NV_T * 5 * DM; e += NGT) { const int c = e % DM, s = (e / DM) % 5, t = e / (5 * DM);
        int l, nwp, jsh, jsc; if (t == 0) { l = 0; nwp = 0; jsh = 0; jsc = 1; } else { const int ls = t - 1, site = ls % 3; l = ls / 3; if (site == 0) { nwp = 2; jsh = 3; jsc = 4; } else if (site == 1) { nwp = 4; jsh = 6; jsc = 7; } else { l = l + 1; nwp = 0; jsh = 0; jsc = 1; } }
        if (l < NLAYER) { GV[e] = a->in[I_NORMW][(size_t)(l * 6 + nwp) * DM + c] * (1.0f + modp(a, l, s, jsc)[c]); SH[e] = modp(a, l, s, jsh)[c]; } else { GV[e] = 0.f; SH[e] = 0.f; } }
}
template <bool INIT, bool POST, bool PRE, bool FINAL>
__device__ __forceinline__ void norm_phase(KP a_in_, int row_lo, int row_hi, int cg_slot, int t_slot) {
    PHASE_IDS();
    float* XR = (float*)(a->ws + WS_XR); const bf16* Y = (const bf16*)(a->ws + WS_Y); bf16* H = (bf16*)(a->ws + WS_H);
    const float* CG = (const float*)(a->ws + WS_NV); const float* GV = CG + (size_t)NLAYER * 3 * 5 * DM; const float* SH = GV + (size_t)NV_T * 5 * DM;
    for (int row = row_lo + gw; row < row_hi; row += NGW) {
        const int s = mod_idx(row);
        f32x4 x[8], cg[8], gv[8], sh[8]; u32x2 yw[8];
        const float* xin = INIT ? (row < M_LAT ? a->in[I_X] + (size_t)row * DM : a->in[I_CTX] + (size_t)(row - M_LAT) * DM) : XR + (size_t)row * DM;
#pragma unroll
        for (int i = 0; i < 8; ++i) x[i] = __builtin_nontemporal_load((const f32x4*)(xin + (i * 64 + lane) * 4));
        f32x4 y[8];
        if (POST) {
            if (row < M_LAT) {
#pragma unroll
                for (int i = 0; i < 8; ++i) yw[i] = __builtin_nontemporal_load((const u32x2*)(Y + (size_t)row * DM + (i * 64 + lane) * 4));
            }
            const float* cgp = CG + ((size_t)cg_slot * 5 + s) * DM;
#pragma unroll
            for (int i = 0; i < 8; ++i) cg[i] = *(const f32x4*)(cgp + (i * 64 + lane) * 4);
        }
        if (PRE) { const float* gvp = GV + ((size_t)t_slot * 5 + s) * DM; const float* shp = SH + ((size_t)t_slot * 5 + s) * DM;
#pragma unroll
            for (int i = 0; i < 8; ++i) { gv[i] = *(const f32x4*)(gvp + (i * 64 + lane) * 4); sh[i] = *(const f32x4*)(shp + (i * 64 + lane) * 4); } }
        if (POST) {
            float ss = 0.f;
            if (row < M_LAT) {
#pragma unroll
                for (int i = 0; i < 8; ++i) y[i] = (f32x4){bflo(yw[i].x), bfhi(yw[i].x), bflo(yw[i].y), bfhi(yw[i].y)};
            } else {
                u32x2 pw[8][4];
#pragma unroll
                for (int i = 0; i < 8; ++i) { const bf16* yp = (const bf16*)(a->ws + WS_YP) + (size_t)(row - M_LAT) * DM + (i * 64 + lane) * 4;
#pragma unroll
                    for (int q = 0; q < 4; ++q) pw[i][q] = *(const u32x2*)(yp + (size_t)q * M_CTX * DM); }
                __builtin_amdgcn_sched_barrier(0);
#pragma unroll
                for (int i = 0; i < 8; ++i) { y[i] = (f32x4){0.f, 0.f, 0.f, 0.f};
#pragma unroll
                    for (int q = 0; q < 4; ++q) { const u32x2 w = pw[i][q]; y[i] += (f32x4){bflo(w.x), bfhi(w.x), bflo(w.y), bfhi(w.y)}; } }
            }
#pragma unroll
            for (int i = 0; i < 8; ++i) ss += y[i][0] * y[i][0] + y[i][1] * y[i][1] + y[i][2] * y[i][2] + y[i][3] * y[i][3];
            const float rs = 1.0f / sqrtf(wave_sum(ss) * (1.0f / DM) + NORM_EPS);
#pragma unroll
            for (int i = 0; i < 8; ++i) x[i] += cg[i] * (y[i] * rs);
        }
        if (FINAL) {
#pragma unroll
            for (int i = 0; i < 8; ++i) __builtin_nontemporal_store(x[i], (f32x4*)(a->out + (size_t)row * DM + (i * 64 + lane) * 4));
        } else if (POST || INIT) {
#pragma unroll
            for (int i = 0; i < 8; ++i) __builtin_nontemporal_store(x[i], (f32x4*)(XR + (size_t)row * DM + (i * 64 + lane) * 4));
        }
        if (PRE) {
            float ss = 0.f;
#pragma unroll
            for (int i = 0; i < 8; ++i) ss += x[i][0] * x[i][0] + x[i][1] * x[i][1] + x[i][2] * x[i][2] + x[i][3] * x[i][3];
            const float rs = 1.0f / sqrtf(wave_sum(ss) * (1.0f / DM) + NORM_EPS);
#pragma unroll
            for (int i = 0; i < 8; ++i) { const f32x4 h = x[i] * rs * gv[i] + sh[i]; u32x2 w; w.x = cvt_pk_bf16(h[0], h[1]); w.y = cvt_pk_bf16(h[2], h[3]); *(u32x2*)(H + (size_t)row * DM + (i * 64 + lane) * 4) = w; }
        }
    }
}

namespace pg8 {
struct EpiQ {
    static constexpr bool PERM = true, AFTER_DRAIN = false, CHAIN = false;
    unsigned char* ws_;
    __device__ __forceinline__ void operator()(const f32x4 (&acc)[2][2][4][2], const Unit& u_, int wr, int wc, int fr, int fq) const {
        Unit u = u_; asm volatile("" : "+s"(u.pm), "+s"(u.pn), "+s"(u.z), "+v"(fr), "+v"(fq));
        unsigned char* ws = ws_; asm volatile("" : "+s"(ws));
        bf16_t* QB = (bf16_t*)(ws + WS_QB); bf16_t* QC = (bf16_t*)(ws + WS_QC); const float* rope = (const float*)(ws + WS_ROPE);
        const int row0 = u.pm * BM + wr * 64 + fr; const bool lat = u.pm < (M_LAT / BM);
#pragma unroll
        for (int bj = 0; bj < 2; ++bj) { const int col = u.pn * BM + bj * HALF + wc * 32 + 8 * fq; const int head = col / 192, within = col - head * 192; const bool rp = within >= 128; const int p0 = (within - 128) >> 1;
#pragma unroll
            for (int ai = 0; ai < 2; ++ai)
#pragma unroll
                for (int m = 0; m < 4; ++m) { const int row = row0 + ai * HALF + m * 16; const f32x4 v0 = acc[ai][bj][m][0], v1 = acc[ai][bj][m][1];
                    float f[8] = {v0[0], v0[1], v0[2], v0[3], v1[0], v1[1], v1[2], v1[3]};
                    bf16_t* dst;
                    if (lat) { const int b = row >> 12, t = row & (TL - 1);
                        if (rp) { const f32x4 co = *(const f32x4*)(rope + (size_t)t * 64 + p0), sn = *(const f32x4*)(rope + (size_t)t * 64 + 32 + p0);
#pragma unroll
                            for (int q = 0; q < 4; ++q) { const float x1 = f[2 * q], x2 = f[2 * q + 1]; f[2 * q] = x1 * co[q] - x2 * sn[q]; f[2 * q + 1] = x1 * sn[q] + x2 * co[q]; } }
                        dst = QB + ((size_t)(b * 4 + head) * TL + t) * 192 + within; }
                    else { const int rr = row - M_LAT, b = rr >> 8, t = rr & (TCX - 1); dst = QC + ((size_t)(b * 4 + head) * TCX + t) * 192 + within; }
                    u32x4 w; w.x = cvt_pk_bf16(f[0], f[1]); w.y = cvt_pk_bf16(f[2], f[3]); w.z = cvt_pk_bf16(f[4], f[5]); w.w = cvt_pk_bf16(f[6], f[7]); *(u32x4*)dst = w; } }
    }
};
struct EpiKV {
    static constexpr bool PERM = true, AFTER_DRAIN = false, CHAIN = false;
    unsigned char* ws_;
    __device__ __forceinline__ void operator()(const f32x4 (&acc)[2][2][4][2], const Unit& u_, int wr, int wc, int fr, int fq) const {
        Unit u = u_; asm volatile("" : "+s"(u.pm), "+s"(u.pn), "+s"(u.z), "+v"(fr), "+v"(fq));
        unsigned char* ws = ws_; asm volatile("" : "+s"(ws));
        bf16_t* KB = (bf16_t*)(ws + WS_KB); bf16_t* VB = (bf16_t*)(ws + WS_VB);
        const int row0 = u.pm * BM + wr * 64 + fr; const bool lat = u.pm < (M_LAT / BM);
#pragma unroll
        for (int bj = 0; bj < 2; ++bj) { const int col = u.pn * BM + bj * HALF + wc * 32 + 8 * fq; const int head = col >> 8, within = col & 255;
#pragma unroll
            for (int ai = 0; ai < 2; ++ai)
#pragma unroll
                for (int m = 0; m < 4; ++m) { const int row = row0 + ai * HALF + m * 16; const f32x4 v0 = acc[ai][bj][m][0], v1 = acc[ai][bj][m][1];
                    int b, key; if (lat) { b = row >> 12; key = row & (TL - 1); } else { const int rr = row - M_LAT; b = rr >> 8; key = TL + (rr & (TCX - 1)); }
                    bf16_t* dst = within < 128 ? KB + ((size_t)(b * 4 + head) * NKEY + key) * 192 + within : VB + ((size_t)(b * 4 + head) * NKEY + key) * 128 + (within - 128);
                    u32x4 w; w.x = cvt_pk_bf16(v0[0], v0[1]); w.y = cvt_pk_bf16(v0[2], v0[3]); w.z = cvt_pk_bf16(v1[0], v1[1]); w.w = cvt_pk_bf16(v1[2], v1[3]); *(u32x4*)dst = w; } }
    }
};
struct EpiLoraW {
    static constexpr bool PERM = true, AFTER_DRAIN = false, CHAIN = false;
    KP a_; int l_; unsigned char* ws_;
    __device__ __forceinline__ void operator()(const f32x4 (&acc)[2][2][4][2], const Unit& u_, int wr, int wc, int fr, int fq) const {
        Unit u = u_; asm volatile("" : "+s"(u.pm), "+s"(u.pn), "+s"(u.z), "+v"(fr), "+v"(fq));
        unsigned char* ws = ws_; KP a = a_; int l = l_; asm volatile("" : "+s"(ws), "+s"(a), "+s"(l));
        const float* w0 = a->in[I_W0] + (size_t)l * 1024; float* W = (float*)(ws + WS_RWW);
        const int row0 = u.pm * BM + wr * 64 + fr; const int d = u.pn >> 1;
#pragma unroll
        for (int bj = 0; bj < 2; ++bj) { const int c = (u.pn & 1) * 256 + bj * HALF + wc * 32 + 8 * fq;
            const f32x4 b0 = *(const f32x4*)(w0 + d * 512 + c), b1 = *(const f32x4*)(w0 + d * 512 + c + 4);
#pragma unroll
            for (int ai = 0; ai < 2; ++ai)
#pragma unroll
                for (int m = 0; m < 4; ++m) { const int row = row0 + ai * HALF + m * 16; const f32x4 v0 = acc[ai][bj][m][0] + b0, v1 = acc[ai][bj][m][1] + b1; f32x4 o0, o1;
#pragma unroll
                    for (int j = 0; j < 4; ++j) { o0[j] = __builtin_amdgcn_exp2f(-0.8750387749f * fast_sigmoid(v0[j])); o1[j] = __builtin_amdgcn_exp2f(-0.8750387749f * fast_sigmoid(v1[j])); }
                    float* dst = W + ((size_t)d * MT + row) * BW + c; *(f32x4*)dst = o0; *(f32x4*)(dst + 4) = o1; } }
    }
};
struct EpiLoraA {
    static constexpr bool PERM = true, AFTER_DRAIN = false, CHAIN = false;
    KP a_; int l_; unsigned char* ws_;
    __device__ __forceinline__ void operator()(const f32x4 (&acc)[2][2][4][2], const Unit& u_, int wr, int wc, int fr, int fq) const {
        Unit u = u_; asm volatile("" : "+s"(u.pm), "+s"(u.pn), "+s"(u.z), "+v"(fr), "+v"(fq));
        unsigned char* ws = ws_; KP a = a_; int l = l_; asm volatile("" : "+s"(ws), "+s"(a), "+s"(l));
        const float* a0 = a->in[I_A0] + (size_t)l * 1024; const float* ka = a->in[I_KA] + (size_t)l * 512;
        const bf16_t* Kb = (const bf16_t*)(ws + WS_RWKB); const bf16_t* KKb = (const bf16_t*)(ws + WS_RWB);
        bf16_t* KD = (bf16_t*)(ws + WS_RWB) + (size_t)3 * MT * BW; bf16_t* BB = (bf16_t*)(ws + WS_RWB) + (size_t)5 * MT * BW;
        const int row0 = u.pm * BM + wr * 64 + fr; const int d = u.pn >> 1;
#pragma unroll
        for (int bj = 0; bj < 2; ++bj) { const int c = (u.pn & 1) * 256 + bj * HALF + wc * 32 + 8 * fq;
            const f32x4 b0 = *(const f32x4*)(a0 + d * 512 + c), b1 = *(const f32x4*)(a0 + d * 512 + c + 4), ka0 = *(const f32x4*)(ka + c), ka1 = *(const f32x4*)(ka + c + 4);
#pragma unroll
            for (int ai = 0; ai < 2; ++ai)
#pragma unroll
                for (int m = 0; m < 4; ++m) { const int row = row0 + ai * HALF + m * 16; const f32x4 v0 = acc[ai][bj][m][0] + b0, v1 = acc[ai][bj][m][1] + b1;
                    const u32x4 kw = *(const u32x4*)(Kb + (size_t)row * BW + c), kkw = *(const u32x4*)(KKb + (size_t)row * BW + c);
                    const float k[8] = {bflo(kw.x), bfhi(kw.x), bflo(kw.y), bfhi(kw.y), bflo(kw.z), bfhi(kw.z), bflo(kw.w), bfhi(kw.w)};
                    const float kk[8] = {bflo(kkw.x), bfhi(kkw.x), bflo(kkw.y), bfhi(kkw.y), bflo(kkw.z), bfhi(kkw.z), bflo(kkw.w), bfhi(kkw.w)};
                    float kd[8], bb[8];
#pragma unroll
                    for (int j = 0; j < 4; ++j) { const float av0 = fast_sigmoid(v0[j]), av1 = fast_sigmoid(v1[j]); kd[j] = k[j] * (1.0f + (av0 - 1.0f) * ka0[j]); kd[4 + j] = k[4 + j] * (1.0f + (av1 - 1.0f) * ka1[j]); bb[j] = kk[j] * av0; bb[4 + j] = kk[4 + j] * av1; }
                    u32x4 w1; w1.x = cvt_pk_bf16(kd[0], kd[1]); w1.y = cvt_pk_bf16(kd[2], kd[3]); w1.z = cvt_pk_bf16(kd[4], kd[5]); w1.w = cvt_pk_bf16(kd[6], kd[7]); *(u32x4*)(KD + ((size_t)d * MT + row) * BW + c) = w1;
                    u32x4 w2; w2.x = cvt_pk_bf16(bb[0], bb[1]); w2.y = cvt_pk_bf16(bb[2], bb[3]); w2.z = cvt_pk_bf16(bb[4], bb[5]); w2.w = cvt_pk_bf16(bb[6], bb[7]); *(u32x4*)(BB + ((size_t)d * MT + row) * BW + c) = w2;
                    asm volatile("" ::: "memory"); } }
    }
};
__device__ __forceinline__ size_t gz_off(int pm, int k, int pn, int g, int wave, int lane) { return ((((size_t)((pm * 4 + k) * 8 + pn) * 16 + g) * 8 + wave) * 64 + lane) * 8; }
struct EpiZ {
    static constexpr bool PERM = true, AFTER_DRAIN = false, CHAIN = false;
    bf16_t* O; bf16_t* GZ; const float* gate_b;
    __device__ __forceinline__ void operator()(const f32x4 (&acc)[2][2][4][2], const Unit& u_, int wr, int wc, int fr, int fq) const {
        Unit u = u_; asm volatile("" : "+s"(u.pm), "+s"(u.pn), "+s"(u.z), "+v"(fr), "+v"(fq));
        if (u.pn < Z_G / BM) {
            const int row0 = u.pm * BM + wr * 64 + fr; const int col0 = u.pn * BM + wc * 32 + 8 * fq;
#pragma unroll
            for (int bj = 0; bj < 2; ++bj)
#pragma unroll
                for (int ai = 0; ai < 2; ++ai)
#pragma unroll
                    for (int m = 0; m < 4; ++m) { const f32x4 v0 = acc[ai][bj][m][0], v1 = acc[ai][bj][m][1];
                        u32x4 w; w.x = cvt_pk_bf16(v0[0], v0[1]); w.y = cvt_pk_bf16(v0[2], v0[3]); w.z = cvt_pk_bf16(v1[0], v1[1]); w.w = cvt_pk_bf16(v1[2], v1[3]);
                        *(u32x4*)(O + (size_t)(row0 + ai * HALF + m * 16) * ZP + col0 + bj * HALF) = w; }
        } else {
            const int t = u.pn - Z_G / BM, k = t >> 3, pn = t & 7, wave = wr * 4 + wc, lane = fq * 16 + fr;
#pragma unroll
            for (int bj = 0; bj < 2; ++bj) { const int c = k * 2048 + pn * BM + bj * HALF + wc * 32 + 8 * fq;
                const f32x4 b0 = *(const f32x4*)(gate_b + c), b1 = *(const f32x4*)(gate_b + c + 4);
#pragma unroll
                for (int ai = 0; ai < 2; ++ai)
#pragma unroll
                    for (int m = 0; m < 4; ++m) { f32x4 v0 = acc[ai][bj][m][0], v1 = acc[ai][bj][m][1];
#pragma unroll
                        for (int j = 0; j < 4; ++j) { v0[j] = fast_sigmoid(fmaxf(v0[j] + b0[j], -60.f)); v1[j] = fast_sigmoid(fmaxf(v1[j] + b1[j], -60.f)); }
                        u32x4 w; w.x = cvt_pk_bf16(v0[0], v0[1]); w.y = cvt_pk_bf16(v0[2], v0[3]); w.z = cvt_pk_bf16(v1[0], v1[1]); w.w = cvt_pk_bf16(v1[2], v1[3]);
                        __builtin_nontemporal_store(w, (u32x4*)(GZ + gz_off(u.pm, k, pn, (bj * 2 + ai) * 4 + m, wave, lane))); } }
        }
    }
};
struct EpiGateH {
    static constexpr bool PERM = true, AFTER_DRAIN = false, CHAIN = true;
    const bf16_t* GZ; bf16_t* MG; int ldc;
#define GH_LD(bt, q) do { _Pragma("unroll") for (int i_ = 0; i_ < 4; ++i_) { za[q][i_] = __builtin_nontemporal_load((const u32x4*)(pa + (size_t)((bt) * 4 + i_) * 4096)); zb[q][i_] = __builtin_nontemporal_load((const u32x4*)(pb + (size_t)((bt) * 4 + i_) * 4096)); } } while (0)
#define GH_MUL(bt, q) do { _Pragma("unroll") for (int m = 0; m < 4; ++m) { const u32x4 a_ = za[q][m], b_ = zb[q][m]; \
        const float ga[8] = {bflo(a_.x), bfhi(a_.x), bflo(a_.y), bfhi(a_.y), bflo(a_.z), bfhi(a_.z), bflo(a_.w), bfhi(a_.w)}; \
        const float gb[8] = {bflo(b_.x), bfhi(b_.x), bflo(b_.y), bfhi(b_.y), bflo(b_.z), bfhi(b_.z), bflo(b_.w), bfhi(b_.w)}; \
        _Pragma("unroll") for (int j = 0; j < 8; ++j) acc[(bt) & 1][(bt) >> 1][m][j >> 2][j & 3] *= ga[j] * __builtin_amdgcn_rcpf(gb[j]); } } while (0)
    __device__ __forceinline__ void mid(f32x4 (&acc)[2][2][4][2], const Unit& u_, int seg, int wr, int wc, int fr, int fq) const {
        Unit u = u_; asm volatile("" : "+s"(u.pm), "+s"(u.pn), "+s"(seg), "+v"(fr), "+v"(fq));
        const int wave = wr * 4 + wc, lane = fq * 16 + fr; const bf16_t* pa = GZ + gz_off(u.pm, seg, u.pn, 0, wave, lane); const bf16_t* pb = GZ + gz_off(u.pm, seg + 1, u.pn, 0, wave, lane);
        u32x4 za[2][4], zb[2][4];
        GH_LD(0, 0); GH_LD(1, 1); __builtin_amdgcn_sched_barrier(0);
        GH_MUL(0, 0); __builtin_amdgcn_sched_barrier(0);
        GH_LD(2, 0); __builtin_amdgcn_sched_barrier(0);
        GH_MUL(1, 1); __builtin_amdgcn_sched_barrier(0);
        GH_LD(3, 1); __builtin_amdgcn_sched_barrier(0);
        GH_MUL(2, 0); __builtin_amdgcn_sched_barrier(0);
        GH_MUL(3, 1);
    }
#undef GH_LD
#undef GH_MUL
    __device__ __forceinline__ void operator()(const f32x4 (&acc)[2][2][4][2], const Unit& u_, int wr, int wc, int fr, int fq) const {
        Unit u = u_; asm volatile("" : "+s"(u.pm), "+s"(u.pn), "+s"(u.z), "+v"(fr), "+v"(fq));
        const int row0 = u.pm * BM + wr * 64 + fr; const int col0 = u.pn * BM + wc * 32 + 8 * fq; const int wave = wr * 4 + wc, lane = fq * 16 + fr;
        const bf16_t* pg = GZ + gz_off(u.pm, 3, u.pn, 0, wave, lane);
        u32x4 zq[16];
#pragma unroll
        for (int g = 0; g < 16; ++g) zq[g] = __builtin_nontemporal_load((const u32x4*)(pg + (size_t)g * 4096));
        __builtin_amdgcn_sched_barrier(0);
#pragma unroll
        for (int bj = 0; bj < 2; ++bj) { const int col = col0 + bj * HALF;
#pragma unroll
            for (int ai = 0; ai < 2; ++ai)
#pragma unroll
                for (int m = 0; m < 4; ++m) { const int row = row0 + ai * HALF + m * 16;
                    const u32x4 zg = zq[(bj * 2 + ai) * 4 + m];
                    const f32x4 v0 = acc[ai][bj][m][0] * (f32x4){bflo(zg.x), bfhi(zg.x), bflo(zg.y), bfhi(zg.y)}, v1 = acc[ai][bj][m][1] * (f32x4){bflo(zg.z), bfhi(zg.z), bflo(zg.w), bfhi(zg.w)};
                    u32x4 w; w.x = cvt_pk_bf16(v0[0], v0[1]); w.y = cvt_pk_bf16(v0[2], v0[3]); w.z = cvt_pk_bf16(v1[0], v1[1]); w.w = cvt_pk_bf16(v1[2], v1[3]);
                    *(u32x4*)(MG + (size_t)row * ldc + col) = w; } }
    }
};
struct EpiLru {
    static constexpr bool PERM = true, AFTER_DRAIN = false, CHAIN = false;
    KP a_; int l_; unsigned char* ws_;
    __device__ __forceinline__ void operator()(const f32x4 (&acc)[2][2][4][2], const Unit& u_, int wr, int wc, int fr, int fq) const {
        Unit u = u_; asm volatile("" : "+s"(u.pm), "+s"(u.pn), "+s"(u.z), "+v"(fr), "+v"(fq));
        unsigned char* ws = ws_; KP a = a_; int l = l_; asm volatile("" : "+s"(ws), "+s"(a), "+s"(l));
        const float* ba = a->in[I_BA] + (size_t)l * 1024; const float* bx = a->in[I_BX] + (size_t)l * 1024; const float* lam = (const float*)(ws + WS_LRUSP) + (size_t)l * 1024;
        const bf16_t* XCVB = (const bf16_t*)(ws + WS_XCVB); float* LRA = (float*)(ws + WS_LRA); float* LRB = (float*)(ws + WS_LRB);
        const int row0 = u.pm * BM + wr * 64 + fr; const int d = u.pn >> 2, c = (u.pn & 3) * 128 + wc * 32 + 8 * fq;
        float sp[8], cba[8], cbx[8];
#pragma unroll
        for (int j = 0; j < 8; ++j) { sp[j] = lam[d * 512 + c + j]; cba[j] = ba[d * 512 + c + j]; cbx[j] = bx[d * 512 + c + j]; }
#pragma unroll
        for (int ai = 0; ai < 2; ++ai)
#pragma unroll
            for (int m = 0; m < 4; ++m) { const int row = row0 + ai * HALF + m * 16; const u32x4 xw = *(const u32x4*)(XCVB + (size_t)row * BW + c);
                const float xc[8] = {bflo(xw.x), bfhi(xw.x), bflo(xw.y), bfhi(xw.y), bflo(xw.z), bfhi(xw.z), bflo(xw.w), bfhi(xw.w)};
                float av[8], bv[8];
#pragma unroll
                for (int j = 0; j < 8; ++j) { const float g_r = fast_sigmoid(acc[ai][0][m][j >> 2][j & 3] + cba[j]), g_i = fast_sigmoid(acc[ai][1][m][j >> 2][j & 3] + cbx[j]);
                    const float a_ = __builtin_amdgcn_exp2f(g_r * sp[j]); av[j] = a_; bv[j] = __builtin_amdgcn_sqrtf(fmaxf(1.0f - a_ * a_, 0.f)) * g_i * xc[j]; }
                float* da = LRA + ((size_t)d * MT + row) * BW + c; float* db = LRB + ((size_t)d * MT + row) * BW + c;
                *(f32x4*)da = (f32x4){av[0], av[1], av[2], av[3]}; *(f32x4*)(da + 4) = (f32x4){av[4], av[5], av[6], av[7]};
                *(f32x4*)db = (f32x4){bv[0], bv[1], bv[2], bv[3]}; *(f32x4*)(db + 4) = (f32x4){bv[4], bv[5], bv[6], bv[7]}; }
    }
};
}

namespace rwc {
__device__ __forceinline__ bf16x8 frag4(unsigned a, unsigned b, unsigned c, unsigned d) { u32x4 w = {a, b, c, d}; return *reinterpret_cast<bf16x8*>(&w); }
__device__ __forceinline__ bf16x8 pack_lo(const f32x4& c) { return frag4(cvt_pk_bf16(c[0], c[1]), cvt_pk_bf16(c[2], c[3]), 0u, 0u); }
__device__ __forceinline__ bf16x8 pack2(const f32x4& lo, const f32x4& hi) { return frag4(cvt_pk_bf16(lo[0], lo[1]), cvt_pk_bf16(lo[2], lo[3]), cvt_pk_bf16(hi[0], hi[1]), cvt_pk_bf16(hi[2], hi[3])); }
__device__ __forceinline__ f32x4 mma(bf16x8 a, bf16x8 b, f32x4 c) { return __builtin_amdgcn_mfma_f32_16x16x32_bf16(a, b, c, 0, 0, 0); }
constexpr int RAW_W = 0, RAW_KK = 4096, RAW_BB = 6144, RAW_KD = 8192, RAW_R = 10240, RAW_V = 12288;
constexpr int TS = 144;
constexpr int A_T = 0, R_T = 16 * TS, B_T = 32 * TS, K_T = 48 * TS, B_TR = 64 * TS, K_TR = B_TR + 64 * 48, CL_O = K_TR + 64 * 48;
}
constexpr int PREP_ITEM = 1024, PREP_BYTES = 10 * PREP_ITEM + 256;
constexpr int NCHK = NSTEP / 16, NJOBS = 64 * NCHK;
__device__ __forceinline__ void rwkv_prep_wave(KP a, int first, int stride, int NJ  , LAS unsigned char* ldsw  , int lane) {
    using namespace rwc;
    const int n = lane & 15, q = lane >> 4;
    if (first >= NJ) return;
    const f32x4 zero4 = (f32x4){0.f, 0.f, 0.f, 0.f};
    const float* RWWp = (const float*)(a->ws + WS_RWW); const bf16* RWB = (const bf16*)(a->ws + WS_RWB);
    u32x4 pw[4], pkk[2], pbb[2], pkd[2], pr[2];
#define RWC_LOAD(job) do { const int chain_ = (job) / NCHK, ch_ = (job) - chain_ * NCHK, d_ = chain_ >> 5, b_ = (chain_ >> 3) & 3, h_ = chain_ & 7, s0_ = ch_ * 16; \
        _Pragma("unroll") for (int i_ = 0; i_ < 4; ++i_) pw[i_] = __builtin_nontemporal_load((const u32x4*)(RWWp + (size_t)d_ * MT * BW + h_ * 64 + (lane & 15) * 4 + (size_t)scan_row(s0_ + 4 * i_ + (lane >> 4), d_, b_) * BW)); \
        _Pragma("unroll") for (int i_ = 0; i_ < 2; ++i_) { const size_t ro_ = (size_t)scan_row(s0_ + 8 * i_ + (lane >> 3), d_, b_) * BW + h_ * 64 + (lane & 7) * 8; \
            pkk[i_] = *(const u32x4*)(RWB + ro_); pbb[i_] = *(const u32x4*)(RWB + (size_t)(5 + d_) * MT * BW + ro_); pkd[i_] = *(const u32x4*)(RWB + (size_t)(3 + d_) * MT * BW + ro_); pr[i_] = *(const u32x4*)(RWB + (size_t)1 * MT * BW + ro_); } } while (0)
#define RWC_STORE_RAW() do { \
        _Pragma("unroll") for (int i_ = 0; i_ < 4; ++i_) *(LAS u32x4*)(ldsw + RAW_W + (i_ * 64 + lane) * 16) = pw[i_]; \
        _Pragma("unroll") for (int i_ = 0; i_ < 2; ++i_) { *(LAS u32x4*)(ldsw + RAW_KK + (i_ * 64 + lane) * 16) = pkk[i_]; *(LAS u32x4*)(ldsw + RAW_BB + (i_ * 64 + lane) * 16) = pbb[i_]; \
            *(LAS u32x4*)(ldsw + RAW_KD + (i_ * 64 + lane) * 16) = pkd[i_]; *(LAS u32x4*)(ldsw + RAW_R + (i_ * 64 + lane) * 16) = pr[i_]; } } while (0)
    RWC_LOAD(first); RWC_STORE_RAW();
    LDS_WAIT(); asm volatile("" ::: "memory");
    for (int job = first; job < NJ; job += stride) {
        if (job + stride < NJ) RWC_LOAD(job + stride);
        float wv[16]; unsigned kkv[16], bbv[16], kdv[16], rv[16];
#pragma unroll
        for (int t = 0; t < 16; ++t) { wv[t] = *(LAS const float*)(ldsw + RAW_W + t * 256 + lane * 4);
            kkv[t] = *(LAS const unsigned short*)(ldsw + RAW_KK + t * 128 + lane * 2); bbv[t] = *(LAS const unsigned short*)(ldsw + RAW_BB + t * 128 + lane * 2);
            kdv[t] = *(LAS const unsigned short*)(ldsw + RAW_KD + t * 128 + lane * 2); rv[t] = *(LAS const unsigned short*)(ldsw + RAW_R + t * 128 + lane * 2); }
        LDS_WAIT(); asm volatile("" ::: "memory");
        {
            float c = 1.0f; unsigned btr[8], ktr[8];
#pragma unroll
            for (int t = 0; t < 16; t += 2) {
                float at[2], bt[2], kt[2], rt[2];
#pragma unroll
                for (int u = 0; u < 2; ++u) { const float cprev = c; c *= wv[t + u]; const float rc = __builtin_amdgcn_rcpf(c);
                    at[u] = -__uint_as_float(kkv[t + u] << 16) * cprev; bt[u] = __uint_as_float(bbv[t + u] << 16) * rc; kt[u] = __uint_as_float(kdv[t + u] << 16) * rc; rt[u] = __uint_as_float(rv[t + u] << 16) * c; }
                const unsigned pa = cvt_pk_bf16(at[0], at[1]), pb = cvt_pk_bf16(bt[0], bt[1]), pk = cvt_pk_bf16(kt[0], kt[1]), pr_ = cvt_pk_bf16(rt[0], rt[1]);
                *(LAS unsigned short*)(ldsw + A_T + t * TS + lane * 2) = (unsigned short)pa; *(LAS unsigned short*)(ldsw + A_T + (t + 1) * TS + lane * 2) = (unsigned short)(pa >> 16);
                *(LAS unsigned short*)(ldsw + R_T + t * TS + lane * 2) = (unsigned short)pr_; *(LAS unsigned short*)(ldsw + R_T + (t + 1) * TS + lane * 2) = (unsigned short)(pr_ >> 16);
                *(LAS unsigned short*)(ldsw + B_T + t * TS + lane * 2) = (unsigned short)pb; *(LAS unsigned short*)(ldsw + B_T + (t + 1) * TS + lane * 2) = (unsigned short)(pb >> 16);
                *(LAS unsigned short*)(ldsw + K_T + t * TS + lane * 2) = (unsigned short)pk; *(LAS unsigned short*)(ldsw + K_T + (t + 1) * TS + lane * 2) = (unsigned short)(pk >> 16);
                btr[t >> 1] = pb; ktr[t >> 1] = pk;
            }
            *(LAS u32x4*)(ldsw + B_TR + lane * 48) = (u32x4){btr[0], btr[1], btr[2], btr[3]}; *(LAS u32x4*)(ldsw + B_TR + lane * 48 + 16) = (u32x4){btr[4], btr[5], btr[6], btr[7]};
            *(LAS u32x4*)(ldsw + K_TR + lane * 48) = (u32x4){ktr[0], ktr[1], ktr[2], ktr[3]}; *(LAS u32x4*)(ldsw + K_TR + lane * 48 + 16) = (u32x4){ktr[4], ktr[5], ktr[6], ktr[7]};
            *(LAS float*)(ldsw + CL_O + lane * 4) = c;
        }
        LDS_WAIT(); asm volatile("" ::: "memory");
        bf16x8 FA[2], FB[2], FK[2], FR[2];
#pragma unroll
        for (int m = 0; m < 2; ++m) { const int o = n * TS + (32 * m + 4 * q) * 2;
            { const u32x2 lo = *(LAS const u32x2*)(ldsw + A_T + o), hi = *(LAS const u32x2*)(ldsw + A_T + o + 32); FA[m] = frag4(lo.x, lo.y, hi.x, hi.y); }
            { const u32x2 lo = *(LAS const u32x2*)(ldsw + B_T + o), hi = *(LAS const u32x2*)(ldsw + B_T + o + 32); FB[m] = frag4(lo.x, lo.y, hi.x, hi.y); }
            { const u32x2 lo = *(LAS const u32x2*)(ldsw + K_T + o), hi = *(LAS const u32x2*)(ldsw + K_T + o + 32); FK[m] = frag4(lo.x, lo.y, hi.x, hi.y); }
            { const u32x2 lo = *(LAS const u32x2*)(ldsw + R_T + o), hi = *(LAS const u32x2*)(ldsw + R_T + o + 32); FR[m] = frag4(lo.x, lo.y, hi.x, hi.y); } }
        f32x4 Nba = mma(FB[1], FA[1], mma(FB[0], FA[0], zero4));
        f32x4 NbaT = mma(FA[1], FB[1], mma(FA[0], FB[0], zero4));
        f32x4 Nka = mma(FK[1], FA[1], mma(FK[0], FA[0], zero4));
        f32x4 Mbr = mma(FB[1], FR[1], mma(FB[0], FR[0], zero4));
        f32x4 Mkr = mma(FK[1], FR[1], mma(FK[0], FR[0], zero4));
#pragma unroll
        for (int r = 0; r < 4; ++r) { const int s = 4 * q + r;
            Nba[r] = s < n ? Nba[r] : 0.f; Nka[r] = s < n ? Nka[r] : 0.f; NbaT[r] = n < s ? NbaT[r] : 0.f; Mbr[r] = s <= n ? Mbr[r] : 0.f; Mkr[r] = s <= n ? Mkr[r] : 0.f; }
        f32x4 Tm;
        {
            f32x4 Id;
#pragma unroll
            for (int r = 0; r < 4; ++r) Id[r] = (4 * q + r == n) ? 1.0f : 0.f;
            const bf16x8 pN = pack_lo(Nba), pNT = pack_lo(NbaT);
            const f32x4 N2 = mma(pNT, pN, zero4), N2T = mma(pN, pNT, zero4);
            const bf16x8 pN2 = pack_lo(N2), pN2T = pack_lo(N2T);
            const f32x4 N4 = mma(pN2T, pN2, zero4), N4T = mma(pN2, pN2T, zero4);
            const bf16x8 pN4 = pack_lo(N4), pN4T = pack_lo(N4T);
            const f32x4 N8 = mma(pN4T, pN4, zero4);
            const bf16x8 pF0T = pack_lo(NbaT + Id), pF1 = pack_lo(N2 + Id);
            const f32x4 T1 = mma(pF0T, pF1, zero4), T1T = mma(pF1, pF0T, zero4);
            const bf16x8 pT1T = pack_lo(T1T), pF2 = pack_lo(N4 + Id);
            const f32x4 T2T = mma(pF2, pT1T, zero4);
            (void)T1;
            const bf16x8 pT2T = pack_lo(T2T), pF3 = pack_lo(N8 + Id);
            Tm = mma(pT2T, pF3, zero4);
        }
        { unsigned char* pp = a->ws + WS_PREP + (size_t)job * PREP_BYTES + lane * 16;
          *(bf16x8*)(pp + 0 * PREP_ITEM) = FA[0]; *(bf16x8*)(pp + 1 * PREP_ITEM) = FA[1]; *(bf16x8*)(pp + 2 * PREP_ITEM) = FR[0]; *(bf16x8*)(pp + 3 * PREP_ITEM) = FR[1];
          *(u32x4*)(pp + 4 * PREP_ITEM) = (u32x4){cvt_pk_bf16(Nka[0], Nka[1]), cvt_pk_bf16(Nka[2], Nka[3]), cvt_pk_bf16(Tm[0], Tm[1]), cvt_pk_bf16(Tm[2], Tm[3])};
          *(bf16x8*)(pp + 5 * PREP_ITEM) = pack2(Mbr, Mkr);
#pragma unroll
          for (int J = 0; J < 4; ++J) { const u32x2 bl = *(LAS const u32x2*)(ldsw + B_TR + (16 * J + n) * 48 + q * 8), kl = *(LAS const u32x2*)(ldsw + K_TR + (16 * J + n) * 48 + q * 8);
              *(u32x4*)(pp + (6 + J) * PREP_ITEM) = (u32x4){bl.x, bl.y, kl.x, kl.y}; }
          ((float*)(a->ws + WS_PREP + (size_t)job * PREP_BYTES + 10 * PREP_ITEM))[lane] = *(LAS const float*)(ldsw + CL_O + lane * 4); }
        LDS_WAIT(); asm volatile("" ::: "memory");
        if (job + stride < NJ) { RWC_STORE_RAW(); LDS_WAIT(); asm volatile("" ::: "memory"); }
    }
#undef RWC_LOAD
#undef RWC_STORE_RAW
}

__device__ __forceinline__ void rwkv_scan_wave(KP a, int chain, int slab, int lane) {
    using namespace rwc;
    const int d = chain >> 5, b = (chain >> 3) & 3, h = chain & 7, n = lane & 15, q = lane >> 4;
    const f32x4 zero4 = (f32x4){0.f, 0.f, 0.f, 0.f};
    const unsigned char* pbase = a->ws + WS_PREP + (size_t)chain * NCHK * PREP_BYTES;
    const bf16* gV = (const bf16*)(a->ws + WS_RWB) + (size_t)2 * MT * BW + h * 64 + slab * 16 + n;
    bf16* gY = (bf16*)(a->ws + WS_RWY) + (size_t)d * MT * BW + h * 64 + slab * 16 + n;
    f32x4 St[4] = {zero4, zero4, zero4, zero4};
    u32x4 eA[3], eB[3], lt[7]; f32x4 cl[4]; unsigned short vvA[4], vvB[4];
#define RWS_LOAD_E(e, vv, ch_) do { const unsigned char* pp_ = pbase + (size_t)(ch_) * PREP_BYTES + lane * 16; \
        e[0] = *(const u32x4*)(pp_ + 0 * PREP_ITEM); e[1] = *(const u32x4*)(pp_ + 1 * PREP_ITEM); e[2] = *(const u32x4*)(pp_ + 4 * PREP_ITEM); \
        _Pragma("unroll") for (int e_ = 0; e_ < 4; ++e_) vv[e_] = gV[(size_t)scan_row((ch_) * 16 + 4 * q + e_, d, b) * BW]; } while (0)
#define RWS_LOAD_L(ch_) do { const unsigned char* pp_ = pbase + (size_t)(ch_) * PREP_BYTES; \
        lt[0] = *(const u32x4*)(pp_ + 2 * PREP_ITEM + lane * 16); lt[1] = *(const u32x4*)(pp_ + 3 * PREP_ITEM + lane * 16); lt[2] = *(const u32x4*)(pp_ + 5 * PREP_ITEM + lane * 16); \
        _Pragma("unroll") for (int i_ = 0; i_ < 4; ++i_) lt[3 + i_] = *(const u32x4*)(pp_ + (6 + i_) * PREP_ITEM + lane * 16); \
        _Pragma("unroll") for (int J_ = 0; J_ < 4; ++J_) cl[J_] = *(const f32x4*)(pp_ + 10 * PREP_ITEM + (16 * J_ + 4 * q) * 4); } while (0)
#define RWS_STEP(e, vv, ch_) do { \
        const bf16x8 FA0 = *reinterpret_cast<bf16x8*>(&e[0]), FA1 = *reinterpret_cast<bf16x8*>(&e[1]), FR0 = *reinterpret_cast<bf16x8*>(&lt[0]), FR1 = *reinterpret_cast<bf16x8*>(&lt[1]); \
        const bf16x8 pNka = frag4(e[2].x, e[2].y, 0u, 0u), pT = frag4(e[2].z, e[2].w, 0u, 0u), pMM = *reinterpret_cast<bf16x8*>(&lt[2]); \
        const bf16x8 BK0 = *reinterpret_cast<bf16x8*>(&lt[3]), BK1 = *reinterpret_cast<bf16x8*>(&lt[4]), BK2 = *reinterpret_cast<bf16x8*>(&lt[5]), BK3 = *reinterpret_cast<bf16x8*>(&lt[6]); \
        const f32x4 c0 = cl[0], c1 = cl[1], c2 = cl[2], c3 = cl[3]; \
        const unsigned Vlo = (unsigned)vv[0] | ((unsigned)vv[1] << 16), Vhi = (unsigned)vv[2] | ((unsigned)vv[3] << 16); \
        if ((ch_) + 2 < NCHK) RWS_LOAD_E(e, vv, (ch_) + 2); \
        if ((ch_) + 1 < NCHK) RWS_LOAD_L((ch_) + 1); \
        const bf16x8 Sb0 = pack2(St[0], St[1]), Sb1 = pack2(St[2], St[3]); \
        f32x4 XT = mma(FA1, Sb1, mma(FA0, Sb0, zero4));                                            \
        XT = mma(pNka, frag4(Vlo, Vhi, 0u, 0u), XT);                                               \
        const f32x4 UT = mma(pT, pack_lo(XT), zero4);                                              \
        const bf16x8 UVb = frag4(cvt_pk_bf16(UT[0], UT[1]), cvt_pk_bf16(UT[2], UT[3]), Vlo, Vhi);     \
        f32x4 YT = mma(FR1, Sb1, mma(FR0, Sb0, zero4)); \
        YT = mma(pMM, UVb, YT); \
        St[0] = mma(BK0, UVb, St[0]) * c0; St[1] = mma(BK1, UVb, St[1]) * c1; St[2] = mma(BK2, UVb, St[2]) * c2; St[3] = mma(BK3, UVb, St[3]) * c3; \
        _Pragma("unroll") for (int r = 0; r < 4; ++r) gY[(size_t)scan_row((ch_) * 16 + 4 * q + r, d, b) * BW] = (bf16)cvt_pk_bf16(YT[r], 0.f); } while (0)
    RWS_LOAD_E(eA, vvA, 0); RWS_LOAD_E(eB, vvB, 1); RWS_LOAD_L(0);
    for (int ch = 0; ch < NCHK; ch += 2) {
        RWS_STEP(eA, vvA, ch);
        RWS_STEP(eB, vvB, ch + 1);
    }
#undef RWS_STEP
#undef RWS_LOAD_E
#undef RWS_LOAD_L
}

__device__ __forceinline__ void thinA_phase(KP a_in_, int l) {
    PHASE_IDS();
    unsigned char* ws = a->ws; const bf16* Z = (const bf16*)(ws + WS_Z);
    bf16* RWB = (bf16*)(ws + WS_RWB);
    for (int row = gw; row < MT; row += NGW) {
        const bf16* zr = Z + (size_t)row * ZP;
        const bool lat = row < M_LAT; int b, t, Tn; if (lat) { b = row >> 12; t = row & (TL - 1); Tn = TL; } else { b = (row - M_LAT) >> 8; t = (row - M_LAT) & (TCX - 1); Tn = TCX; }
        const bool hasp = t > 0, hasn = t < Tn - 1;
        {
            float q0[8], q1[8]; ld8bf(zr + lane * 8, q0); float ss = 0.f;
#pragma unroll
            for (int i = 0; i < 8; ++i) ss += q0[i] * q0[i];
            if (lane < 32) { ld8bf(zr + 512 + lane * 8, q1);
#pragma unroll
                for (int i = 0; i < 8; ++i) ss += q1[i] * q1[i]; }
            const float rs = 1.0f / sqrtf(wave_sum(ss) * (1.0f / 768.0f) + NORM_EPS);
            const float* qn = a->in[I_QNORM] + (size_t)l * 768; float g[8];
            ld8f(qn + lane * 8, g);
#pragma unroll
            for (int i = 0; i < 8; ++i) q0[i] *= rs * g[i];
            st8bf((bf16*)(ws + WS_CQN) + (size_t)row * 768 + lane * 8, q0);
            if (lane < 32) { ld8f(qn + 512 + lane * 8, g);
#pragma unroll
                for (int i = 0; i < 8; ++i) q1[i] *= rs * g[i];
                st8bf((bf16*)(ws + WS_CQN) + (size_t)row * 768 + 512 + lane * 8, q1); }
            float kv[8]; ld8bf(zr + Z_CKV + lane * 8, kv); float s2 = 0.f;
#pragma unroll
            for (int i = 0; i < 8; ++i) s2 += kv[i] * kv[i];
            const float rs2 = 1.0f / sqrtf(wave_sum(s2) * (1.0f / 512.0f) + NORM_EPS);
            ld8f(a->in[I_KVNORM] + (size_t)l * 512 + lane * 8, g);
#pragma unroll
            for (int i = 0; i < 8; ++i) kv[i] *= rs2 * g[i];
            st8bf((bf16*)(ws + WS_CKVN) + (size_t)row * 512 + lane * 8, kv);
        }
        if (lane < 8) { float f[8]; ld8bf(zr + Z_KR + lane * 8, f); const int key = lat ? t : TL + t;
            if (lat) { const float* rp = (const float*)(ws + WS_ROPE) + (size_t)t * 64 + lane * 4; const f32x4 co = *(const f32x4*)rp, sn = *(const f32x4*)(rp + 32);
#pragma unroll
                for (int q = 0; q < 4; ++q) { const float x1 = f[2 * q], x2 = f[2 * q + 1]; f[2 * q] = x1 * co[q] - x2 * sn[q]; f[2 * q + 1] = x1 * sn[q] + x2 * co[q]; } }
#pragma unroll
            for (int hh = 0; hh < 4; ++hh) st8bf((bf16*)(ws + WS_KB) + ((size_t)(b * 4 + hh) * NKEY + key) * 192 + 128 + lane * 8, f); }
        {
            const float* mu = a->in[I_MU] + (size_t)l * 2 * 1792;
#pragma unroll
            for (int i = 0; i < 4; ++i) {
                const int c = i * 512 + lane * 8;
                if (i < 3 || lane < 32) {
                    float z[8], zp[8], zn[8], mp[8], mn[8];
                    ld8bf(zr + Z_RW + c, z);
                    if (hasp) ld8bf(zr - ZP + Z_RW + c, zp); else {
#pragma unroll
                        for (int q = 0; q < 8; ++q) zp[q] = 0.f; }
                    if (hasn) ld8bf(zr + ZP + Z_RW + c, zn); else {
#pragma unroll
                        for (int q = 0; q < 8; ++q) zn[q] = 0.f; }
                    ld8f(mu + c, mp); ld8f(mu + 1792 + c, mn);
#pragma unroll
                    for (int q = 0; q < 8; ++q) z[q] = z[q] + (zp[q] - z[q]) * mp[q] + (zn[q] - z[q]) * mn[q];
                    if (i == 0) st8bf(RWB + 1 * (size_t)MT * BW + (size_t)row * BW + lane * 8, z);
                    else if (i == 1) { st8bf((bf16*)(ws + WS_RWKB) + (size_t)row * BW + lane * 8, z);
                        float kk[8], g[8]; ld8f(a->in[I_KK] + (size_t)l * 512 + lane * 8, g); float ss = 0.f;
#pragma unroll
                        for (int q = 0; q < 8; ++q) { kk[q] = z[q] * g[q]; ss += kk[q] * kk[q]; }
                        const float rn = 1.0f / sqrtf(sum8(ss) + 1e-12f);
#pragma unroll
                        for (int q = 0; q < 8; ++q) kk[q] *= rn;
                        st8bf(RWB + (size_t)row * BW + lane * 8, kk); }
                    else if (i == 2) st8bf(RWB + 2 * (size_t)MT * BW + (size_t)row * BW + lane * 8, z);
                    else {
#pragma unroll
                        for (int q = 0; q < 8; ++q) z[q] = lane < 8 ? (1.0f - 2.0f * fast_sigmoid(-2.0f * z[q])) : (lane < 16 ? z[q] : fast_sigmoid(z[q]));
                        st8bf((bf16*)(ws + WS_LIN) + (size_t)row * 256 + lane * 8, z); }
                }
            }
        }
        {
            const int c = lane * 8; float acc[8], w[8], x[8];
            ld8f(a->in[I_CONVB] + (size_t)l * 512 + c, acc);
            const float* cw = a->in[I_CONVW] + (size_t)l * 4 * 512 + c;
#pragma unroll
            for (int j = 0; j < 4; ++j) { const int tt = t + j - 2;
                if (tt >= 0 && tt < Tn) { ld8bf(zr + (ptrdiff_t)(j - 2) * ZP + Z_LX + c, x); ld8f(cw + j * 512, w);
#pragma unroll
                    for (int q = 0; q < 8; ++q) acc[q] += x[q] * w[q]; } }
            st8bf((bf16*)(ws + WS_XCVB) + (size_t)row * BW + c, acc);
        }
    }
}

__device__ __forceinline__ void bf8f(const u32x4 v, float (&f)[8]) { f[0] = bflo(v.x); f[1] = bfhi(v.x); f[2] = bflo(v.y); f[3] = bfhi(v.y); f[4] = bflo(v.z); f[5] = bfhi(v.z); f[6] = bflo(v.w); f[7] = bfhi(v.w); }
template <bool S5P, bool BP>
__device__ __forceinline__ void thinC_rows(KP a_in_, int l, int row0, int row_end, int step) {
    PHASE_IDS();
    unsigned char* ws = a->ws; const bf16* Z = (const bf16*)(ws + WS_Z); const bf16* RWB = (const bf16*)(ws + WS_RWB);
    bf16* YS = (bf16*)(ws + WS_YS);
    const int c = lane * 8;
    float rk[8], lw[8], lb[8], dd[8];
    if (BP) { ld8f(a->in[I_RK] + (size_t)l * 512 + c, rk); ld8f(a->in[I_LNW] + (size_t)l * 512 + c, lw); ld8f(a->in[I_LNB] + (size_t)l * 512 + c, lb); }
    if (S5P) ld8f(a->in[I_S5D] + (size_t)l * 512 + c, dd);
#define TC_NT(p_) __builtin_nontemporal_load((const u32x4*)(p_))
#define TC_LOAD(R, row_) do { const size_t ro_ = (size_t)(row_) * BW + c; \
        if (BP) { R[0] = TC_NT((const bf16*)(ws + WS_RWY) + ro_); R[1] = TC_NT((const bf16*)(ws + WS_RWY) + (size_t)MT * BW + ro_); \
            R[2] = TC_NT(RWB + (size_t)1 * MT * BW + ro_); R[3] = TC_NT(RWB + (size_t)2 * MT * BW + ro_); R[4] = TC_NT(RWB + (size_t)3 * MT * BW + ro_); R[5] = TC_NT(RWB + (size_t)4 * MT * BW + ro_); \
            R[6] = TC_NT((const bf16*)(ws + WS_G) + ro_); \
            R[10] = TC_NT((const bf16*)(ws + WS_LRH) + ro_); R[11] = TC_NT((const bf16*)(ws + WS_LRH) + (size_t)MT * BW + ro_); R[12] = TC_NT(Z + (size_t)(row_) * ZP + Z_LG + c); } \
        if (S5P) { R[7] = TC_NT(Z + (size_t)(row_) * ZP + Z_S5 + c); R[8] = TC_NT((const bf16*)(ws + WS_S5Y) + ro_); R[9] = TC_NT((const bf16*)(ws + WS_S5Y) + (size_t)MT * BW + ro_); } } while (0)
    int row = row0 + wave; u32x4 cur[13];
    { unsigned z_ = 0u; asm volatile("" : "+v"(z_));
#pragma unroll
      for (int i = 0; i < 13; ++i) cur[i] = (u32x4){z_, z_, z_, z_}; }
    if (row < row_end) TC_LOAD(cur, row);
    for (; row < row_end; row += step) {
        u32x4 nxt[13];
#pragma unroll
        for (int i = 0; i < 13; ++i) nxt[i] = cur[i];
        if (row + step < row_end) TC_LOAD(nxt, row + step);
        __builtin_amdgcn_sched_barrier(0);
        const size_t ro = (size_t)row * BW + c;
        if (BP) { float y0[8], y1[8], r[8], v[8], kd0[8], kd1[8], g[8], o[8];
          bf8f(cur[0], y0); bf8f(cur[1], y1); bf8f(cur[2], r); bf8f(cur[3], v); bf8f(cur[4], kd0); bf8f(cur[5], kd1); bf8f(cur[6], g);
          float s = 0.f, bsum = 0.f;
#pragma unroll
          for (int q = 0; q < 8; ++q) { y0[q] += y1[q]; s += y0[q]; bsum += r[q] * (kd0[q] + kd1[q]) * rk[q]; }
          const float mean = sum8(s) * (1.0f / 64.0f); bsum = sum8(bsum); float vs = 0.f;
#pragma unroll
          for (int q = 0; q < 8; ++q) { const float dlt = y0[q] - mean; vs += dlt * dlt; }
          const float rstd = 1.0f / sqrtf(sum8(vs) * (1.0f / 64.0f) + 64e-5f);
#pragma unroll
          for (int q = 0; q < 8; ++q) o[q] = ((y0[q] - mean) * rstd * lw[q] + lb[q] + bsum * v[q]) * g[q];
          st8bf(YS + (size_t)1 * MT * BW + ro, o); }
        if (S5P) { float u[8], y0[8], y1[8], o[8]; bf8f(cur[7], u); bf8f(cur[8], y0); bf8f(cur[9], y1);
#pragma unroll
          for (int q = 0; q < 8; ++q) o[q] = gelu_tanh(u[q] * dd[q] + y0[q] + y1[q]);
          st8bf((bf16*)(ws + WS_TG) + ro, o); }
        if (BP) { float h0[8], h1[8], g[8], o[8]; bf8f(cur[10], h0); bf8f(cur[11], h1); bf8f(cur[12], g);
#pragma unroll
          for (int q = 0; q < 8; ++q) o[q] = (h0[q] + h1[q]) * gelu_tanh(g[q]);
          st8bf(YS + (size_t)3 * MT * BW + ro, o); }
        __builtin_amdgcn_sched_barrier(0);
#pragma unroll
        for (int i = 0; i < 13; ++i) cur[i] = nxt[i];
    }
#undef TC_LOAD
#undef TC_NT
}

__device__ __forceinline__ float dpp_sum16(float v) {
    v += __builtin_bit_cast(float, __builtin_amdgcn_update_dpp(0, __builtin_bit_cast(int, v), 0xB1, 0xF, 0xF, true));
    v += __builtin_bit_cast(float, __builtin_amdgcn_update_dpp(0, __builtin_bit_cast(int, v), 0x4E, 0xF, 0xF, true));
    v += __builtin_bit_cast(float, __builtin_amdgcn_update_dpp(0, __builtin_bit_cast(int, v), 0x141, 0xF, 0xF, true));
    v += __builtin_bit_cast(float, __builtin_amdgcn_update_dpp(0, __builtin_bit_cast(int, v), 0x140, 0xF, 0xF, true));
    return v;
}
__device__ __forceinline__ void rwkv_chain(KP a_in_, int unit, LAS unsigned char* ldsb) {
    PHASE_IDS();
    const int chain = unit >> 1, hf = unit & 1;
    const int ir = lane >> 4, cg = lane & 15;
    const int d = chain >> 5, b = (chain >> 3) & 3, h = chain & 7;
    const int myrow = hf * 32 + wave * 4 + ir;
    bf16* Yg = (bf16*)(a->ws + WS_RWY) + (size_t)d * MT * BW + h * 64 + hf * 32;
    LAS float* buf = (LAS float*)ldsb;
    LAS float* ybuf = (LAS float*)(ldsb + 2 * 16 * 6 * 64 * 4);
    const float* srcw = (const float*)(a->ws + WS_RWW) + (size_t)d * MT * BW + h * 64 + (tid & 15) * 4; const int wstep = (tid >> 4) & 15; const int wdst = (wstep * 6 + 2) * 64 + (tid & 15) * 4;
    const bf16* RWB = (const bf16*)(a->ws + WS_RWB);
    int bstep[2], bdst[2]; const bf16* bsrc[2];
#pragma unroll
    for (int q = 0; q < 2; ++q) { const int id = tid + 512 * q, v = id >> 7, st = (id >> 3) & 15, c8 = id & 7;
        const int arr = v == 0 ? 0 : (v == 1 ? 5 + d : (v == 2 ? 3 + d : (v == 3 ? 1 : 2))); const int slot = v == 0 ? 0 : (v == 1 ? 1 : (v == 2 ? 3 : (v == 3 ? 4 : 5)));
        bstep[q] = st; bdst[q] = (st * 6 + slot) * 64 + c8 * 8; bsrc[q] = RWB + (size_t)arr * MT * BW + h * 64 + c8 * 8; }
    const bool second = tid < 128;
    const int ystep = tid >> 5, yrow = tid & 31;
    f32x2 S01 = (f32x2){0.f, 0.f}, S23 = (f32x2){0.f, 0.f};
    f32x4 nw = (f32x4){0.f, 0.f, 0.f, 0.f}; u32x4 nb0 = (u32x4){0u, 0u, 0u, 0u}, nb1 = (u32x4){0u, 0u, 0u, 0u};
#define RWKV_LOAD(s0) do { if (tid < 256) nw = *(const f32x4*)(srcw + (size_t)scan_row((s0) + wstep, d, b) * BW); \
        nb0 = *(const u32x4*)(bsrc[0] + (size_t)scan_row((s0) + bstep[0], d, b) * BW); if (second) nb1 = *(const u32x4*)(bsrc[1] + (size_t)scan_row((s0) + bstep[1], d, b) * BW); } while (0)
#define RWKV_WRITE(dstbuf) do { if (tid < 256) *(LAS f32x4*)((dstbuf) + wdst) = nw; \
        *(LAS f32x4*)((dstbuf) + bdst[0]) = (f32x4){bflo(nb0.x), bfhi(nb0.x), bflo(nb0.y), bfhi(nb0.y)}; *(LAS f32x4*)((dstbuf) + bdst[0] + 4) = (f32x4){bflo(nb0.z), bfhi(nb0.z), bflo(nb0.w), bfhi(nb0.w)}; \
        if (second) { *(LAS f32x4*)((dstbuf) + bdst[1]) = (f32x4){bflo(nb1.x), bfhi(nb1.x), bflo(nb1.y), bfhi(nb1.y)}; *(LAS f32x4*)((dstbuf) + bdst[1] + 4) = (f32x4){bflo(nb1.z), bfhi(nb1.z), bflo(nb1.w), bfhi(nb1.w)}; } } while (0)
    RWKV_LOAD(0); RWKV_WRITE(buf);
    __syncthreads();
    constexpr int NCH = NSTEP / 16;
    for (int ch = 0; ch < NCH; ++ch) {
        LAS const float* cb = buf + (ch & 1) * (16 * 6 * 64);
        LAS float* yb = ybuf + (ch & 1) * (16 * 32 * 16);
        if (ch + 1 < NCH) RWKV_LOAD((ch + 1) * 16);
#pragma unroll
        for (int s = 0; s < 16; ++s) {
            LAS const float* v6 = cb + s * 6 * 64 + cg * 4;
            const f32x4 a4 = *(LAS const f32x4*)(v6), b4 = *(LAS const f32x4*)(v6 + 64), w4 = *(LAS const f32x4*)(v6 + 128), k4 = *(LAS const f32x4*)(v6 + 192), r4 = *(LAS const f32x4*)(v6 + 256);
            const float vv = cb[s * 6 * 64 + 320 + myrow];
            f32x2 t = S01 * (f32x2){a4[0], a4[1]} + S23 * (f32x2){a4[2], a4[3]};
            const float sa = -dpp_sum16(t[0] + t[1]);
            const f32x2 sav = (f32x2){sa, sa}, vvv = (f32x2){vv, vv};
            S01 = S01 * (f32x2){w4[0], w4[1]} + sav * (f32x2){b4[0], b4[1]} + vvv * (f32x2){k4[0], k4[1]};
            S23 = S23 * (f32x2){w4[2], w4[3]} + sav * (f32x2){b4[2], b4[3]} + vvv * (f32x2){k4[2], k4[3]};
            f32x2 u = S01 * (f32x2){r4[0], r4[1]} + S23 * (f32x2){r4[2], r4[3]};
            yb[(s * 32 + wave * 4 + ir) * 16 + cg] = u[0] + u[1];
        }
        if (ch + 1 < NCH) { LAS float* nbuf = buf + ((ch + 1) & 1) * (16 * 6 * 64); RWKV_WRITE(nbuf); }
        __syncthreads();
        { LAS const f32x4* yp = (LAS const f32x4*)(yb + (ystep * 32 + yrow) * 16); const f32x4 p0 = yp[0], p1 = yp[1], p2 = yp[2], p3 = yp[3];
          Yg[(size_t)scan_row(ch * 16 + ystep, d, b) * BW + yrow] = (bf16)cvt_pk_bf16(((p0[0] + p0[1]) + (p0[2] + p0[3])) + ((p1[0] + p1[1]) + (p1[2] + p1[3])) + ((p2[0] + p2[1]) + (p2[2] + p2[3])) + ((p3[0] + p3[1]) + (p3[2] + p3[3])), 0.f); }
    }
}

__device__ __forceinline__ void s5_disc(KP a, int l, int d, int g, int p, float& ar, float& ai, float& cr, float& ci) {
    const f32x4 v = *(const f32x4*)((const float*)(a->ws + WS_S5D) + ((size_t)((l * 2 + d) * 32 + g) * 64 + p) * 4); ar = v[0]; ai = v[1]; cr = v[2]; ci = v[3];
}
__device__ __forceinline__ void s5_chain(KP a, int l, int chain, LAS unsigned char* ldsw  , int lane) {
    const int d = chain >> 7, b = (chain >> 5) & 3, g = chain & 31, n16 = lane & 15, kq = lane >> 4;
    const size_t gi = (size_t)(l * 2 + d) * 32 + g;
    constexpr int DST = 132;
    float ar, ai, crp, cip; s5_disc(a, l, d, g, lane, ar, ai, crp, cip);
    bf16x8 Bf[8], Cf[4];
#pragma unroll
    for (int nb = 0; nb < 8; ++nb) { const int pp = 16 * nb + n16, p = pp & 63; float f[8];
        if (kq < 2) { float xr, xi, cr, ci; s5_disc(a, l, d, g, p, xr, xi, cr, ci); float bre[8], bim[8];
            ld8f(a->in[I_BRE] + (gi * 64 + p) * 16 + 8 * kq, bre); ld8f(a->in[I_BIM] + (gi * 64 + p) * 16 + 8 * kq, bim);
#pragma unroll
            for (int j = 0; j < 8; ++j) f[j] = pp < 64 ? (cr * bre[j] - ci * bim[j]) : (cr * bim[j] + ci * bre[j]); }
        else {
#pragma unroll
            for (int j = 0; j < 8; ++j) f[j] = 0.f; }
        u32x4 w; w.x = cvt_pk_bf16(f[0], f[1]); w.y = cvt_pk_bf16(f[2], f[3]); w.z = cvt_pk_bf16(f[4], f[5]); w.w = cvt_pk_bf16(f[6], f[7]); Bf[nb] = *reinterpret_cast<bf16x8*>(&w); }
#pragma unroll
    for (int ks = 0; ks < 4; ++ks) { const int p0 = 32 * ks + 8 * kq; float f[8];
        if (p0 < 64) ld8f(a->in[I_CRE] + (gi * 16 + n16) * 64 + p0, f); else { ld8f(a->in[I_CIM] + (gi * 16 + n16) * 64 + (p0 - 64), f);
#pragma unroll
            for (int j = 0; j < 8; ++j) f[j] = -f[j]; }
        u32x4 w; w.x = cvt_pk_bf16(f[0], f[1]); w.y = cvt_pk_bf16(f[2], f[3]); w.z = cvt_pk_bf16(f[4], f[5]); w.w = cvt_pk_bf16(f[6], f[7]); Cf[ks] = *reinterpret_cast<bf16x8*>(&w); }
    const bf16* Z = (const bf16*)(a->ws + WS_Z) + Z_S5 + g * 16 + 8 * (kq & 1);
    bf16* Yo = (bf16*)(a->ws + WS_S5Y) + (size_t)d * MT * BW + g * 16 + n16;
    constexpr int HST = 272;
    LAS float* Dsb0 = (LAS float*)ldsw; LAS float* Dsb1 = (LAS float*)(ldsw + 16 * DST * 4);
    LAS unsigned char* Hs0 = ldsw + 2 * 16 * DST * 4; LAS unsigned char* Hs1 = Hs0 + 16 * HST;
    const unsigned umask = kq < 2 ? 0xffffffffu : 0u;
    constexpr int NCH5 = NSTEP / 16;
#define S5_LOADU(c_) (*(const u32x4*)(Z + (size_t)scan_row((c_) * 16 + n16, d, b) * ZP))
#define S5_DRIVE(uw_, Dd_) do { u32x4 u_ = (uw_); u_.x &= umask; u_.y &= umask; u_.z &= umask; u_.w &= umask; const bf16x8 Uf_ = *reinterpret_cast<const bf16x8*>(&u_); \
        _Pragma("unroll") for (int nb = 0; nb < 8; ++nb) { const f32x4 D_ = __builtin_amdgcn_mfma_f32_16x16x32_bf16(Uf_, Bf[nb], (f32x4){0.f, 0.f, 0.f, 0.f}, 0, 0, 0); \
            _Pragma("unroll") for (int r = 0; r < 4; ++r) (Dd_)[(4 * kq + r) * DST + 16 * nb + n16] = D_[r]; } } while (0)
#define S5_READOUT(Hh_, c_) do { f32x4 Yv_ = (f32x4){0.f, 0.f, 0.f, 0.f}; \
        _Pragma("unroll") for (int ks = 0; ks < 4; ++ks) Yv_ = __builtin_amdgcn_mfma_f32_16x16x32_bf16(*(LAS const bf16x8*)((Hh_) + n16 * HST + (32 * ks + 8 * kq) * 2), Cf[ks], Yv_, 0, 0, 0); \
        _Pragma("unroll") for (int r = 0; r < 4; ++r) Yo[(size_t)scan_row((c_) * 16 + 4 * kq + r, d, b) * BW] = (bf16)cvt_pk_bf16(Yv_[r], 0.f); } while (0)
    float hr = 0.f, hi = 0.f;
    u32x4 unext = S5_LOADU(0);
    S5_DRIVE(unext, Dsb0);
    unext = S5_LOADU(1);
    LDS_WAIT(); asm volatile("" ::: "memory");
    for (int ch = 0; ch < NCH5; ++ch) {
        LAS float* Dc = (ch & 1) ? Dsb1 : Dsb0; LAS float* Dn = (ch & 1) ? Dsb0 : Dsb1;
        LAS unsigned char* Hc = (ch & 1) ? Hs1 : Hs0; LAS unsigned char* Hp = (ch & 1) ? Hs0 : Hs1;
        if (ch > 0) S5_READOUT(Hp, ch - 1);
        if (ch + 1 < NCH5) { S5_DRIVE(unext, Dn); if (ch + 2 < NCH5) unext = S5_LOADU(ch + 2); }
#pragma unroll
        for (int t = 0; t < 16; t += 2) {
            float h0r, h0i, h1r, h1i;
            { const float dre = Dc[t * DST + lane], dim = Dc[t * DST + 64 + lane]; h0r = ar * hr - ai * hi + dre; h0i = ar * hi + ai * hr + dim; }
            { const float dre = Dc[(t + 1) * DST + lane], dim = Dc[(t + 1) * DST + 64 + lane]; h1r = ar * h0r - ai * h0i + dre; h1i = ar * h0i + ai * h0r + dim; }
            hr = h1r; hi = h1i;
            const unsigned pr_ = cvt_pk_bf16(h0r, h1r), pi_ = cvt_pk_bf16(h0i, h1i);
            *(LAS unsigned short*)(Hc + t * HST + lane * 2) = (unsigned short)pr_; *(LAS unsigned short*)(Hc + (t + 1) * HST + lane * 2) = (unsigned short)(pr_ >> 16);
            *(LAS unsigned short*)(Hc + t * HST + 128 + lane * 2) = (unsigned short)pi_; *(LAS unsigned short*)(Hc + (t + 1) * HST + 128 + lane * 2) = (unsigned short)(pi_ >> 16);
        }
        LDS_WAIT(); asm volatile("" ::: "memory");
    }
    S5_READOUT(((NCH5 - 1) & 1) ? Hs1 : Hs0, NCH5 - 1);
#undef S5_LOADU
#undef S5_DRIVE
#undef S5_READOUT
}

__device__ __forceinline__ void lru_unit(KP a_in_, int unit, LAS unsigned char* ldsb) {
    PHASE_IDS();
    const int d = unit >> 5, b = (unit >> 3) & 3, c = (unit & 7) * 64 + lane;
    const float* A = (const float*)(a->ws + WS_LRA) + (size_t)d * MT * BW + c; const float* Bv = (const float*)(a->ws + WS_LRB) + (size_t)d * MT * BW + c; bf16* Hv = (bf16*)(a->ws + WS_LRH) + (size_t)d * MT * BW + c;
    LAS f32x2* xch = (LAS f32x2*)ldsb;
    float carry = 0.f;
    float av[32], bv[32];
#pragma unroll
    for (int i = 0; i < 32; ++i) { const size_t ro = (size_t)scan_row(wave * 32 + i, d, b) * BW; av[i] = __builtin_nontemporal_load(A + ro); bv[i] = __builtin_nontemporal_load(Bv + ro); }
    constexpr int NSB = NSTEP / 256;
    for (int sb = 0; sb < NSB; ++sb) {
        float hl[32], pl[32]; float h = 0.f, p = 1.f;
#pragma unroll
        for (int i = 0; i < 32; ++i) { h = av[i] * h + bv[i]; p = av[i] * p; hl[i] = h; pl[i] = p; }
        LAS f32x2* xb = xch + (sb & 1) * 512;
        xb[wave * 64 + lane] = (f32x2){p, h};
        if (sb + 1 < NSB) {
#pragma unroll
            for (int i = 0; i < 32; ++i) { const size_t ro = (size_t)scan_row((sb + 1) * 256 + wave * 32 + i, d, b) * BW; av[i] = __builtin_nontemporal_load(A + ro); bv[i] = __builtin_nontemporal_load(Bv + ro); } }
        __syncthreads();
        float cin = carry, c8 = carry;
#pragma unroll
        for (int u = 0; u < 8; ++u) { const f32x2 e = xb[u * 64 + lane]; c8 = e[0] * c8 + e[1]; if (u < wave) cin = c8; }
        carry = c8;
#pragma unroll
        for (int i = 0; i < 32; ++i) Hv[(size_t)scan_row(sb * 256 + wave * 32 + i, d, b) * BW] = (bf16)cvt_pk_bf16(hl[i] + pl[i] * cin, 0.f);
    }
}

constexpr int CV_STATIC_RW = 256;
constexpr int CV_STATIC_JOBS = 384;
__device__ __forceinline__ void mixer_phase(KP a_in_, int l, int qslot, unsigned char* lds_generic, LAS unsigned char* ldsb, volatile LAS unsigned* misc, bool attn_only = false) {
    PHASE_IDS(); const int blk = attn_only ? 100000 : bx_;
    if (blk < 64) {
        rwkv_prep_wave(a, blk * NCHK + wave, 8, (blk + 1) * NCHK, ldsb + wave * 16384, lane);
        asm volatile("s_waitcnt vmcnt(0)" ::: "memory");
        volatile LAS unsigned* cnt = misc + 24 + l;
        if (lane == 0) __hip_atomic_fetch_add((LAS unsigned*)cnt, 1u, __ATOMIC_RELAXED, __HIP_MEMORY_SCOPE_WORKGROUP);
        if (wave < 4) {
            for (unsigned sp = 0; *cnt < 8u && sp < (1u << 24); ++sp) __builtin_amdgcn_s_sleep(2);
            __builtin_amdgcn_fence(__ATOMIC_ACQUIRE, "agent"); asm volatile("s_waitcnt vmcnt(0)" ::: "memory");
            rwkv_scan_wave(a, blk, wave, lane);
        } else if (l < NLAYER - 1 && !attn_only) {
            for (int k = 0; k < CV_STATIC_RW * 8 / 256; ++k) convert_wave(a, l + 1, (LAS float*)(ldsb + wave * 16384), CV_STATIC_JOBS * 8 + blk * 4 + (wave - 4) + 256 * k, 8192, lane); }
    }
    else if (blk < 128) {
        if (wave < 4) s5_chain(a, l, (blk - 64) * 4 + wave, ldsb + wave * 25600, lane);
        else if (l < NLAYER - 1 && !attn_only) { LAS float* scr = (LAS float*)(ldsb + (wave < 7 ? 102400 + (wave - 4) * 8448 : 132352));
            for (int k = 0; k < CV_STATIC_JOBS * 8 / 256; ++k) convert_wave(a, l + 1, scr, (blk - 64) * 4 + (wave - 4) + 256 * k, 8192, lane); } }
    else if (blk < 192) lru_unit(a, blk - 128, ldsb);
    __syncthreads();
    const int nunits = 256 + (l < NLAYER - 1 ? 16 : 0);
    const int njobs = (l < NLAYER - 1 && !attn_only) ? 1024 - CV_STATIC_JOBS - CV_STATIC_RW : 0;
    unsigned* qctr = (unsigned*)(a->ws + WS_CTL) + CW_Q + 64 * qslot;
    for (;;) {
        if (tid == 0) misc[16] = __hip_atomic_fetch_add(qctr, 1u, __ATOMIC_RELAXED, __HIP_MEMORY_SCOPE_AGENT);
        __syncthreads();
        const int u = (int)misc[16];
        __syncthreads();
        if (u >= nunits + njobs) break;
        if (u >= nunits) { convert_weights(a, l + 1, ldsb, CV_STATIC_JOBS + CV_STATIC_RW + u - nunits, 1024); __syncthreads(); continue; }
        if (u < 256) { const int bh = u >> 4, qb = u & 15, b = bh >> 2, h = bh & 3;
            att::attn_unit((const bf16*)(a->ws + WS_QB) + ((size_t)bh * TL + qb * 256) * 192, (const bf16*)(a->ws + WS_KB) + (size_t)bh * NKEY * 192, (const bf16*)(a->ws + WS_VB) + (size_t)bh * NKEY * 128,
                           (bf16*)(a->ws + WS_YS) + ((size_t)(b * TL + qb * 256)) * BW + h * 128, BW, NKEY, (char*)lds_generic);
        } else { const int bh = u - 256, b = bh >> 2, h = bh & 3;
            att::attn_unit((const bf16*)(a->ws + WS_QC) + (size_t)bh * TCX * 192, (const bf16*)(a->ws + WS_KB) + ((size_t)bh * NKEY + TL) * 192, (const bf16*)(a->ws + WS_VB) + ((size_t)bh * NKEY + TL) * 128,
                           (bf16*)(a->ws + WS_YS) + ((size_t)(M_LAT + b * TCX)) * BW + h * 128, BW, TCX, (char*)lds_generic);
        }
    }
}

struct LruOrder {
    pg8::StaticOrder S;
    __device__ __forceinline__ bool next(int i, pg8::Unit& u) const { const bool r = S.next(i, u); u.z = u.pn & 3; return r; }
    __device__ __forceinline__ void a_ready(const pg8::Unit&) const {}
    __device__ __forceinline__ void done(const pg8::Unit&) const {}
};
#ifndef PROBE_DUP_MERGE
#define PROBE_DUP_MERGE 0
#endif
#ifndef PROBE_DUP_GEMM
#define PROBE_DUP_GEMM 0
#endif
#ifndef PROBE_DUP_THIN
#define PROBE_DUP_THIN 0
#endif
#ifndef PROBE_DUP_CONV
#define PROBE_DUP_CONV 0
#endif
#ifndef PROBE_DUP_ATTN
#define PROBE_DUP_ATTN 0
#endif
#ifndef PROBE_DUP_MIXER
#define PROBE_DUP_MIXER 0
#endif
#ifndef MK_MULTI
#define MK_MULTI 0
#endif
constexpr int NPH_LAYER = 15, NPHASES = 3 + NLAYER * NPH_LAYER;
__global__ void __launch_bounds__(NWAVES * 64, 2) mega_fwd(KArgs a_by_value_unused) {
    KP a_in_ = (KP)__builtin_amdgcn_kernarg_segment_ptr(); LAUNDER_A();
    extern __shared__ __attribute__((aligned(16))) unsigned char lds[];
    LAS unsigned char* ldsb = (LAS unsigned char*)lds;
    volatile LAS unsigned* MISC = (volatile LAS unsigned*)(ldsb + MISC_OFF);
    { const int tid0 = threadIdx.x;
      for (int u = tid0; u < (LDS_BYTES - 131072) / 4; u += NWAVES * 64) ((LAS unsigned*)(ldsb + 131072))[u] = 0u;
      __syncthreads();
      if ((tid0 & 63) == 0) ((volatile LAS int*)(WAVE_TAB_OFF))[(unsigned)__builtin_amdgcn_s_getreg((5 << 11) | 4) & 63u] = tid0 >> 6;
      __syncthreads(); }
    unsigned* ctl = (unsigned*)(a->ws + WS_CTL);
    XcdBarrier bar; bar.bar = ctl + CW_BAR; bar.x = 0; bar.st = nullptr;
    if (!MK_MULTI) bar = xcd_barrier_post(ctl + CW_BAR, MISC + 8);
#if MK_MULTI
    const int lo = a->ph_lo, hi = a->ph_hi;
#define IN(k) (lo <= (k) && (k) < hi)
#define SEAM(k) do { if (IN((k) + 1)) xcd_barrier(bar); } while (0)
#else
#define IN(k) true
#define SEAM(k) xcd_barrier(bar)
#endif

    if (IN(0)) {
        tables_phase(a);
        for (int rep_ = 0; rep_ <= PROBE_DUP_CONV; ++rep_) {
        { const int nx_ = NLAYER * 72 - (int)gridDim.x;
          if (nx_ > 0 && 2 * nx_ < (int)gridDim.x) { if ((int)blockIdx.x >= nx_) convert_weights(a, 0, ldsb, (int)blockIdx.x - nx_, (int)gridDim.x - nx_); }
          else convert_weights(a, 0, ldsb, (int)blockIdx.x, (int)gridDim.x); }
        __syncthreads();
        mod_phase(a, ldsb); __syncthreads(); }
        SEAM(0);
    }
    if (IN(1)) { normvec_phase(a); SEAM(1); }
    if (IN(2)) { norm_phase<true, false, true, false>(a, 0, MT, 0, 0); SEAM(2); }

    for (int l = 0; l < NLAYER; ++l) {
        const int pb = 3 + l * NPH_LAYER;
        const bool lastl = (l == NLAYER - 1);
        const int Mpost = lastl ? M_LAT : MT;
        if (IN(pb + 0)) { LAUNDER_A(); unsigned char* ws = a->ws; unsigned char* wsw = ws + wset_off(l & 1); (void)wsw; bf16* H = (bf16*)(ws + WS_H); bf16* Y = (bf16*)(ws + WS_Y); bf16* U = (bf16*)(ws + WS_U); bf16* Zb = (bf16*)(ws + WS_Z); (void)H; (void)Y; (void)U; (void)Zb; int BX = blockIdx.x; asm volatile("" : "+s"(BX)); int G = gridDim.x; asm volatile("" : "+s"(G)); pg8::Gemm g{H, (const bf16*)(wsw + WS_W13), MT, 11264, 2048, 2048, 0, 0}; pg8::StaticOrder S; S.init(MT, 11264, G, BX);
            pg8::EpiSwiGLU E{U, DFF}; for (int rep_ = 0; rep_ <= PROBE_DUP_GEMM; ++rep_) pg8::gemm_phase<pg8::EpiSwiGLU, pg8::StaticOrder, true, true>(ldsb, g, S, E); SEAM(pb + 0); }
        if (IN(pb + 1)) { LAUNDER_A(); unsigned char* ws = a->ws; unsigned char* wsw = ws + wset_off(l & 1); (void)wsw; bf16* H = (bf16*)(ws + WS_H); bf16* Y = (bf16*)(ws + WS_Y); bf16* U = (bf16*)(ws + WS_U); bf16* Zb = (bf16*)(ws + WS_Z); (void)H; (void)Y; (void)U; (void)Zb; int BX = blockIdx.x; asm volatile("" : "+s"(BX)); int G = gridDim.x; asm volatile("" : "+s"(G));
            { pg8::Gemm g{U, (const bf16*)(wsw + WS_W2), M_LAT, 2048, DFF, DFF, 0, 0}; pg8::StaticOrder S; S.init(M_LAT, 2048, G, BX);
              pg8::EpiBf16 E{Y, DM, 0}; pg8::gemm_phase<pg8::EpiBf16, pg8::StaticOrder, true, true>(ldsb, g, S, E); }
            { pg8::Gemm g{U + (size_t)M_LAT * DFF, (const bf16*)(wsw + WS_W2), M_CTX, 2048, DFF / 4, DFF, (size_t)(DFF / 4) * 2, (size_t)(DFF / 4) * 2}; pg8::StaticOrder S; S.init(M_CTX, 2048, G, BX, 4, true);
              pg8::EpiBf16 E{(bf16*)(ws + WS_YP), DM, (size_t)M_CTX * DM}; pg8::gemm_phase<pg8::EpiBf16, pg8::StaticOrder, true, true>(ldsb, g, S, E); }
            SEAM(pb + 1); }
        if (IN(pb + 2)) { LAUNDER_A(); unsigned char* ws = a->ws; unsigned char* wsw = ws + wset_off(l & 1); (void)wsw; bf16* H = (bf16*)(ws + WS_H); bf16* Y = (bf16*)(ws + WS_Y); bf16* U = (bf16*)(ws + WS_U); bf16* Zb = (bf16*)(ws + WS_Z); (void)H; (void)Y; (void)U; (void)Zb; int BX = blockIdx.x; asm volatile("" : "+s"(BX)); int G = gridDim.x; asm volatile("" : "+s"(G)); norm_phase<false, true, true, false>(a, 0, MT, l * 3 + 0, 1 + l * 3 + 0); SEAM(pb + 2); }
        if (IN(pb + 3)) { LAUNDER_A(); unsigned char* ws = a->ws; unsigned char* wsw = ws + wset_off(l & 1); (void)wsw; bf16* H = (bf16*)(ws + WS_H); bf16* Y = (bf16*)(ws + WS_Y); bf16* U = (bf16*)(ws + WS_U); bf16* Zb = (bf16*)(ws + WS_Z); (void)H; (void)Y; (void)U; (void)Zb; int BX = blockIdx.x; asm volatile("" : "+s"(BX)); int G = gridDim.x; asm volatile("" : "+s"(G)); pg8::Gemm g{H, (const bf16*)(wsw + WS_WIN), MT, NZW, 2048, 2048, 0, 0}; pg8::StaticOrder S; S.init(MT, NZW, G, BX);
            pg8::EpiZ E{Zb, (bf16*)(ws + WS_GZ), a->in[I_GATEB] + (size_t)l * 4 * DM}; for (int rep_ = 0; rep_ <= PROBE_DUP_GEMM; ++rep_) pg8::gemm_phase<pg8::EpiZ, pg8::StaticOrder, true, true>(ldsb, g, S, E); SEAM(pb + 3); }
        if (IN(pb + 4)) { LAUNDER_A(); unsigned char* ws = a->ws; unsigned char* wsw = ws + wset_off(l & 1); (void)wsw; bf16* H = (bf16*)(ws + WS_H); bf16* Y = (bf16*)(ws + WS_Y); bf16* U = (bf16*)(ws + WS_U); bf16* Zb = (bf16*)(ws + WS_Z); (void)H; (void)Y; (void)U; (void)Zb; int BX = blockIdx.x; asm volatile("" : "+s"(BX)); int G = gridDim.x; asm volatile("" : "+s"(G)); for (int rep_ = 0; rep_ <= PROBE_DUP_THIN; ++rep_) thinA_phase(a, l); SEAM(pb + 4); }
        if (IN(pb + 5)) { LAUNDER_A(); unsigned char* ws = a->ws; unsigned char* wsw = ws + wset_off(l & 1); (void)wsw; bf16* H = (bf16*)(ws + WS_H); bf16* Y = (bf16*)(ws + WS_Y); bf16* U = (bf16*)(ws + WS_U); bf16* Zb = (bf16*)(ws + WS_Z); (void)H; (void)Y; (void)U; (void)Zb; int BX = blockIdx.x; asm volatile("" : "+s"(BX)); int G = gridDim.x; asm volatile("" : "+s"(G));
            { pg8::Gemm g{(const bf16*)(ws + WS_CQN), (const bf16*)(wsw + WS_WUQ), MT, 768, 768, 768, 0, 0}; pg8::StaticOrder S; S.init(MT, 768, G, (BX + 52) % G);
              pg8::EpiQ E{ws}; for (int rep_ = 0; rep_ <= PROBE_DUP_GEMM; ++rep_) pg8::gemm_phase<pg8::EpiQ, pg8::StaticOrder, true, true>(ldsb, g, S, E); }
            { pg8::Gemm g{(const bf16*)(ws + WS_CKVN), (const bf16*)(wsw + WS_WUKV), MT, 1024, 512, 512, 0, 0}; pg8::StaticOrder S; S.init(MT, 1024, G, (BX + 104) % G);
              pg8::EpiKV E{ws}; for (int rep_ = 0; rep_ <= PROBE_DUP_GEMM; ++rep_) pg8::gemm_phase<pg8::EpiKV, pg8::StaticOrder, true, true>(ldsb, g, S, E); }
            { pg8::Gemm g{(const bf16*)(ws + WS_LIN), (const bf16*)(wsw + WS_WLORA), MT, 1024, 128, 256, 0, 0}; pg8::StaticOrder S; S.init(MT, 1024, G, (BX + 172) % G);
              pg8::EpiLoraW E{a, l, ws}; for (int rep_ = 0; rep_ <= PROBE_DUP_GEMM; ++rep_) pg8::gemm_phase<pg8::EpiLoraW, pg8::StaticOrder, true, true>(ldsb, g, S, E); }
            { pg8::Gemm g{(const bf16*)(ws + WS_LIN), (const bf16*)(wsw + WS_WLORA) + (size_t)1024 * 256, MT, 1024, 128, 256, 0, 0}; pg8::StaticOrder S; S.init(MT, 1024, G, (BX + 156) % G);
              pg8::EpiLoraA E{a, l, ws}; for (int rep_ = 0; rep_ <= PROBE_DUP_GEMM; ++rep_) pg8::gemm_phase<pg8::EpiLoraA, pg8::StaticOrder, true, true>(ldsb, g, S, E); }
            { pg8::Gemm g{(const bf16*)(ws + WS_LIN) + 128, (const bf16*)(wsw + WS_WLORA) + (size_t)2048 * 256 + 128, MT, 512, 128, 256, 0, 0}; pg8::StaticOrder S; S.init(MT, 512, G, (BX + 52) % G);
              pg8::EpiBf16 E{(bf16*)(ws + WS_G), BW, 0}; for (int rep_ = 0; rep_ <= PROBE_DUP_GEMM; ++rep_) pg8::gemm_phase<pg8::EpiBf16, pg8::StaticOrder, true, true>(ldsb, g, S, E); }
            { int K_ = 128; asm volatile("" : "+s"(K_));
              pg8::Gemm g{(const bf16*)(ws + WS_XCVB), (const bf16*)(wsw + WS_WLRU), MT, 2048, K_, 512, (size_t)128 * 2, (size_t)128 * 2}; LruOrder S; S.S.init(MT, 2048, G, (BX + 84) % G);
              pg8::EpiLru E{a, l, ws};
              for (int rep_ = 0; rep_ <= PROBE_DUP_GEMM; ++rep_) pg8::gemm_phase<pg8::EpiLru, LruOrder, true, true>(ldsb, g, S, E); }
            SEAM(pb + 5); }
        if (IN(pb + 6)) { LAUNDER_A(); unsigned char* ws = a->ws; unsigned char* wsw = ws + wset_off(l & 1); (void)wsw; bf16* H = (bf16*)(ws + WS_H); bf16* Y = (bf16*)(ws + WS_Y); bf16* U = (bf16*)(ws + WS_U); bf16* Zb = (bf16*)(ws + WS_Z); (void)H; (void)Y; (void)U; (void)Zb; int BX = blockIdx.x; asm volatile("" : "+s"(BX)); int G = gridDim.x; asm volatile("" : "+s"(G)); mixer_phase(a, l, l, lds, ldsb, MISC);
#if PROBE_DUP_MIXER
            xcd_barrier(bar); mixer_phase(a, l, l + 4, lds, ldsb, MISC);
#endif
#if PROBE_DUP_ATTN
            xcd_barrier(bar); mixer_phase(a, l, l + 4, lds, ldsb, MISC, true);
#endif
            SEAM(pb + 6); }
        if (IN(pb + 7)) { LAUNDER_A(); unsigned char* ws = a->ws; unsigned char* wsw = ws + wset_off(l & 1); int BX = blockIdx.x; asm volatile("" : "+s"(BX)); int G = gridDim.x; asm volatile("" : "+s"(G));
            pg8::Gemm g{(const bf16*)(ws + WS_TG), (const bf16*)(wsw + WS_WGLU), Mpost, 512, 512, 512, 0, 0}; pg8::StaticOrder S; S.init(Mpost, 512, G, BX);
            const int nA = (Mpost / 256) * 2;
            if (BX < nA) { pg8::Unit u0; (void)S.next(0, u0); const int pm0 = __builtin_amdgcn_readfirstlane(u0.pm);
                thinC_rows<true, false>(a, l, pm0 * 256, pm0 * 256 + 256, NWAVES);
                asm volatile("s_waitcnt vmcnt(0)" ::: "memory"); __syncthreads();
                pg8::EpiGlu E{(bf16*)(ws + WS_YS) + (size_t)2 * MT * BW, (const bf16*)(ws + WS_TG), BW, a->in[I_GLUB] + (size_t)l * 512};
                pg8::gemm_phase<pg8::EpiGlu, pg8::StaticOrder, true, true>(ldsb, g, S, E); }
            if (G == 256) { const int ra = 40, rb = lastl ? 88 : 100;
              int lo = BX < nA ? BX * ra : nA * ra + (BX - nA) * rb; int hi = lo + (BX < nA ? ra : rb); if (hi > Mpost) hi = Mpost;
              thinC_rows<false, true>(a, l, lo, hi, NWAVES); }
            else thinC_rows<false, true>(a, l, BX * NWAVES, Mpost, G * NWAVES);
            SEAM(pb + 7); }
        if (IN(pb + 9)) { LAUNDER_A(); unsigned char* ws = a->ws; unsigned char* wsw = ws + wset_off(l & 1); (void)wsw; bf16* H = (bf16*)(ws + WS_H); bf16* Y = (bf16*)(ws + WS_Y); bf16* U = (bf16*)(ws + WS_U); bf16* Zb = (bf16*)(ws + WS_Z); (void)H; (void)Y; (void)U; (void)Zb; int BX = blockIdx.x; asm volatile("" : "+s"(BX)); int G = gridDim.x; asm volatile("" : "+s"(G)); pg8::Gemm g{(const bf16*)(ws + WS_YS), (const bf16*)(wsw + WS_WBR), Mpost, 2048, 512, 512, (size_t)MT * BW * 2, (size_t)2048 * 512 * 2}; pg8::StaticOrder S; S.init(Mpost, 2048, G, BX);
            pg8::EpiGateH E{(const bf16*)(ws + WS_GZ), (bf16*)(ws + WS_MG), DM};
            for (int rep_ = 0; rep_ <= PROBE_DUP_MERGE; ++rep_) pg8::gemm_phase<pg8::EpiGateH, pg8::StaticOrder, true, true, 4, 8>(ldsb, g, S, E); SEAM(pb + 9); }
        if (IN(pb + 10)) { LAUNDER_A(); unsigned char* ws = a->ws; unsigned char* wsw = ws + wset_off(l & 1); (void)wsw; bf16* H = (bf16*)(ws + WS_H); bf16* Y = (bf16*)(ws + WS_Y); bf16* U = (bf16*)(ws + WS_U); bf16* Zb = (bf16*)(ws + WS_Z); (void)H; (void)Y; (void)U; (void)Zb; int BX = blockIdx.x; asm volatile("" : "+s"(BX)); int G = gridDim.x; asm volatile("" : "+s"(G));
            { pg8::Gemm g{(const bf16*)(ws + WS_MG), (const bf16*)(wsw + WS_WOUT), M_LAT, 2048, 2048, 2048, 0, 0}; pg8::StaticOrder S; S.init(M_LAT, 2048, G, BX);
              pg8::EpiBf16 E{Y, DM, 0}; pg8::gemm_phase<pg8::EpiBf16, pg8::StaticOrder, true, true>(ldsb, g, S, E); }
            if (!lastl) { pg8::Gemm g{(const bf16*)(ws + WS_MG) + (size_t)M_LAT * DM, (const bf16*)(wsw + WS_WOUT), M_CTX, 2048, 512, 2048, (size_t)512 * 2, (size_t)512 * 2}; pg8::StaticOrder S; S.init(M_CTX, 2048, G, BX, 4, true);
              pg8::EpiBf16 E{(bf16*)(ws + WS_YP), DM, (size_t)M_CTX * DM}; pg8::gemm_phase<pg8::EpiBf16, pg8::StaticOrder, true, true>(ldsb, g, S, E); }
            SEAM(pb + 10); }
        if (IN(pb + 11)) { LAUNDER_A(); unsigned char* ws = a->ws; unsigned char* wsw = ws + wset_off(l & 1); (void)wsw; bf16* H = (bf16*)(ws + WS_H); bf16* Y = (bf16*)(ws + WS_Y); bf16* U = (bf16*)(ws + WS_U); bf16* Zb = (bf16*)(ws + WS_Z); (void)H; (void)Y; (void)U; (void)Zb; int BX = blockIdx.x; asm volatile("" : "+s"(BX)); int G = gridDim.x; asm volatile("" : "+s"(G)); norm_phase<false, true, true, false>(a, 0, Mpost, l * 3 + 1, 1 + l * 3 + 1); SEAM(pb + 11); }
        if (IN(pb + 12)) { LAUNDER_A(); unsigned char* ws = a->ws; unsigned char* wsw = ws + wset_off(l & 1); (void)wsw; bf16* H = (bf16*)(ws + WS_H); bf16* Y = (bf16*)(ws + WS_Y); bf16* U = (bf16*)(ws + WS_U); bf16* Zb = (bf16*)(ws + WS_Z); (void)H; (void)Y; (void)U; (void)Zb; int BX = blockIdx.x; asm volatile("" : "+s"(BX)); int G = gridDim.x; asm volatile("" : "+s"(G)); pg8::Gemm g{H, (const bf16*)(wsw + WS_W13) + (size_t)11264 * 2048, Mpost, 11264, 2048, 2048, 0, 0}; pg8::StaticOrder S; S.init(Mpost, 11264, G, BX);
            pg8::EpiSwiGLU E{U, DFF}; for (int rep_ = 0; rep_ <= PROBE_DUP_GEMM; ++rep_) pg8::gemm_phase<pg8::EpiSwiGLU, pg8::StaticOrder, true, true>(ldsb, g, S, E); SEAM(pb + 12); }
        if (IN(pb + 13)) { LAUNDER_A(); unsigned char* ws = a->ws; unsigned char* wsw = ws + wset_off(l & 1); (void)wsw; bf16* H = (bf16*)(ws + WS_H); bf16* Y = (bf16*)(ws + WS_Y); bf16* U = (bf16*)(ws + WS_U); bf16* Zb = (bf16*)(ws + WS_Z); (void)H; (void)Y; (void)U; (void)Zb; int BX = blockIdx.x; asm volatile("" : "+s"(BX)); int G = gridDim.x; asm volatile("" : "+s"(G));
            { pg8::Gemm g{U, (const bf16*)(wsw + WS_W2) + (size_t)2048 * 5632, M_LAT, 2048, DFF, DFF, 0, 0}; pg8::StaticOrder S; S.init(M_LAT, 2048, G, BX);
              pg8::EpiBf16 E{Y, DM, 0}; pg8::gemm_phase<pg8::EpiBf16, pg8::StaticOrder, true, true>(ldsb, g, S, E); }
            if (!lastl) { pg8::Gemm g{U + (size_t)M_LAT * DFF, (const bf16*)(wsw + WS_W2) + (size_t)2048 * 5632, M_CTX, 2048, DFF / 4, DFF, (size_t)(DFF / 4) * 2, (size_t)(DFF / 4) * 2}; pg8::StaticOrder S; S.init(M_CTX, 2048, G, BX, 4, true);
              pg8::EpiBf16 E{(bf16*)(ws + WS_YP), DM, (size_t)M_CTX * DM}; pg8::gemm_phase<pg8::EpiBf16, pg8::StaticOrder, true, true>(ldsb, g, S, E); }
            SEAM(pb + 13); }
        if (IN(pb + 14)) { LAUNDER_A(); unsigned char* ws = a->ws; unsigned char* wsw = ws + wset_off(l & 1); (void)wsw; bf16* H = (bf16*)(ws + WS_H); bf16* Y = (bf16*)(ws + WS_Y); bf16* U = (bf16*)(ws + WS_U); bf16* Zb = (bf16*)(ws + WS_Z); (void)H; (void)Y; (void)U; (void)Zb; int BX = blockIdx.x; asm volatile("" : "+s"(BX)); int G = gridDim.x; asm volatile("" : "+s"(G));
            if (!lastl) { norm_phase<false, true, true, false>(a, 0, MT, l * 3 + 2, 1 + l * 3 + 2); }
            else norm_phase<false, true, false, true>(a, 0, M_LAT, l * 3 + 2, 0);
            if (!lastl) SEAM(pb + 14); }
    }
#undef IN
#undef SEAM
}

extern "C" void kernel_launch(void* const* d_in, const int* in_sizes, int n_in, void* d_out, int out_size, void* d_ws, size_t ws_size, hipStream_t stream) {
    static int grid = 0;
    if (grid == 0) {
        if (n_in != N_INPUTS || out_size != M_LAT * DM || ws_size < WS_END) { fprintf(stderr, "kernel_launch: unexpected shapes (n_in %d, out %d, ws %zu < %zu)\n", n_in, out_size, ws_size, (size_t)WS_END); grid = -1; return; }
        int dev = 0, cus = 0;
        if (hipGetDevice(&dev) != hipSuccess || hipDeviceGetAttribute(&cus, hipDeviceAttributeMultiprocessorCount, dev) != hipSuccess) { grid = -1; return; }
        if (hipFuncSetAttribute((const void*)mega_fwd, hipFuncAttributeMaxDynamicSharedMemorySize, LDS_BYTES) != hipSuccess) { fprintf(stderr, "kernel_launch: hipFuncSetAttribute failed\n"); grid = -1; return; }
        int per_cu = 0;
        if (hipOccupancyMaxActiveBlocksPerMultiprocessor(&per_cu, (const void*)mega_fwd, NWAVES * 64, LDS_BYTES) != hipSuccess || per_cu < 1) fprintf(stderr, "kernel_launch: occupancy query reports %d\n", per_cu);
        (void)hipGetLastError();
        if (cus < 256) { fprintf(stderr, "kernel_launch: built for a 256-CU device (the mixer phase deals scan roles to workgroups 0..191); found %d CUs, nothing launched\n", cus); grid = -1; return; }
        grid = cus;
    }
    if (grid < 0) return;
    (void)hipMemsetAsync((char*)d_ws + WS_CTL, 0, CTL_BYTES, stream);
    KArgs a{};
    for (int i = 0; i < N_INPUTS; ++i) a.in[i] = (const float*)d_in[i];
    a.out = (float*)d_out; a.ws = (unsigned char*)d_ws;
#if MK_MULTI
    for (int k = 0; k < NPHASES; ++k) { a.ph_lo = k; a.ph_hi = k + 1; hipLaunchKernelGGL(mega_fwd, dim3(grid), dim3(NWAVES * 64), LDS_BYTES, stream, a); }
#else
    a.ph_lo = 0; a.ph_hi = NPHASES;
    hipLaunchKernelGGL(mega_fwd, dim3(grid), dim3(NWAVES * 64), LDS_BYTES, stream, a);
#endif
}
```

```cpp
#include <hip/hip_runtime.h>
#include <cstdio>
#include <cstdint>

#define LAS __attribute__((address_space(3)))
#define GAS __attribute__((address_space(1)))
typedef unsigned short bf16;
typedef short bf16x8 __attribute__((ext_vector_type(8)));
typedef short s16x4 __attribute__((ext_vector_type(4)));
typedef float f32x2 __attribute__((ext_vector_type(2)));
typedef float f32x4 __attribute__((ext_vector_type(4)));
typedef float f32x16 __attribute__((ext_vector_type(16)));
typedef unsigned u32x2 __attribute__((ext_vector_type(2)));
typedef unsigned u32x4 __attribute__((ext_vector_type(4)));

typedef __bf16 bf16n2 __attribute__((ext_vector_type(2)));
__device__ __forceinline__ unsigned cvt_pk_bf16(float lo, float hi) { const bf16n2 v = __builtin_convertvector((f32x2){lo, hi}, bf16n2); return __builtin_bit_cast(unsigned, v); }
__device__ __forceinline__ float bflo(unsigned w) { return __uint_as_float(w << 16); }
__device__ __forceinline__ float bfhi(unsigned w) { return __uint_as_float(w & 0xffff0000u); }
__device__ __forceinline__ float fast_sigmoid(float x) { return __builtin_amdgcn_rcpf(1.0f + __builtin_amdgcn_exp2f(-1.4426950408889634f * x)); }
__device__ __forceinline__ float gelu_tanh(float x) { const float u = 0.7978845608028654f * (x + 0.044715f * x * x * x); const float e = __builtin_amdgcn_exp2f(-2.8853900817779268f * u); return x * __builtin_amdgcn_rcpf(1.0f + e); }

constexpr unsigned WAVE_TAB_OFF = 131072 + 1024;
__device__ __forceinline__ int hw_tid() {
    const unsigned slot = (unsigned)__builtin_amdgcn_s_getreg((5 << 11) | 4) & 63u;
    const int wave = ((volatile LAS int*)(WAVE_TAB_OFF))[slot];
    int lane_; asm volatile("v_mbcnt_lo_u32_b32 %0, -1, 0\n\tv_mbcnt_hi_u32_b32 %0, -1, %0" : "=v"(lane_));
    return __builtin_amdgcn_readfirstlane(wave) * 64 + lane_;
}
namespace pg8 {
#define PG8_LAS __attribute__((address_space(3)))
typedef unsigned short bf16_t;
constexpr int BM = 256, BK = 64, HALF = 128, HTB = HALF * BK * 2  , STAGE_BYTES = 8 * HTB, NXCD = 8, WGM = 4;

__host__ __device__ __forceinline__ int lds_byte(int r, int c) { const int st = (r >> 4) * 2 + (c >> 5), rr = r & 15, cc = c & 31, ob = rr * 64 + cc * 2; return st * 1024 + (ob ^ (((ob >> 9) & 1) << 5)); }
__host__ __device__ __forceinline__ void stage_rc(int b, int& R, int& C) { const int st = b / 1024, sb = b % 1024, swz = sb ^ (((sb >> 9) & 1) << 5); R = (st >> 1) * 16 + swz / 64; C = (st & 1) * 32 + (swz % 64) / 2; }
__host__ __device__ __forceinline__ int perm32(int rho) { const int n = rho >> 4, i = rho & 15; return 8 * (i >> 2) + 4 * n + (i & 3); }

struct Unit { int pm, pn, z; };
struct Gemm { const bf16_t* A; const bf16_t* Bt; int M, N, K, ld; size_t sA, sB; };

struct StaticOrder {
    int nM, nN, nz, nwg, G, c; bool zs;
    __host__ __device__ void init(int M, int N, int G_, int c_, int nz_ = 1, bool zs_ = false) { nM = M / BM; nN = N / BM; nz = nz_; nwg = nM * nN; G = G_; c = c_; zs = zs_; }
    __host__ __device__ __forceinline__ bool next(int i, Unit& u) const {
        long L;
        if (zs) { const long Lz = (long)i * G + c; if (Lz >= (long)nwg * nz) return false; L = Lz / nz; u.z = (int)(Lz - L * nz); }
        else { const int ti = i / nz; u.z = i - ti * nz; L = (long)ti * G + c; if (L >= nwg) return false; }
        int wgid = (int)L; { const int q = nwg / NXCD, r = nwg % NXCD, xcd = wgid % NXCD, off = wgid / NXCD; wgid = (xcd < r ? xcd * (q + 1) : r * (q + 1) + (xcd - r) * q) + off; }
        const int nig = WGM * nN, gid = wgid / nig, fm = gid * WGM, gsz = (nM - fm) < WGM ? (nM - fm) : WGM;
        u.pm = fm + ((wgid % nig) % gsz); u.pn = (wgid % nig) / gsz; return true;
    }
    __device__ __forceinline__ void a_ready(const Unit&) const {}
    __device__ __forceinline__ void done(const Unit&) const {}
};

struct EpiBf16 {
    static constexpr bool PERM = true, AFTER_DRAIN = false, CHAIN = false;
    bf16_t* O; int ldc; size_t zstride;
    __device__ __forceinline__ void operator()(const f32x4 (&acc)[2][2][4][2], const Unit& u, int wr, int wc, int fr, int fq) const {
        const int row0 = u.pm * BM + wr * 64 + fr; const int col0 = u.pn * BM + wc * 32 + 8 * fq;
#pragma unroll
        for (int ai = 0; ai < 2; ++ai)
#pragma unroll
            for (int m = 0; m < 4; ++m) { bf16_t* rowp = O + (size_t)u.z * zstride + (size_t)(row0 + ai * HALF + m * 16) * ldc + col0;
#pragma unroll
                for (int bj = 0; bj < 2; ++bj) { const f32x4 v0 = acc[ai][bj][m][0], v1 = acc[ai][bj][m][1];
                    u32x4 w; w.x = cvt_pk_bf16(v0[0], v0[1]); w.y = cvt_pk_bf16(v0[2], v0[3]); w.z = cvt_pk_bf16(v1[0], v1[1]); w.w = cvt_pk_bf16(v1[2], v1[3]);
                    *(u32x4*)(rowp + bj * HALF) = w; } }
    }
};
struct EpiSwiGLU {
    static constexpr bool PERM = true, AFTER_DRAIN = false, CHAIN = false;
    bf16_t* O; int ldc;
    __device__ __forceinline__ void operator()(const f32x4 (&acc)[2][2][4][2], const Unit& u, int wr, int wc, int fr, int fq) const {
        const int row0 = u.pm * BM + wr * 64 + fr; const int col0 = u.pn * HALF + wc * 32 + 8 * fq;
#pragma unroll
        for (int ai = 0; ai < 2; ++ai)
#pragma unroll
            for (int m = 0; m < 4; ++m) { bf16_t* rowp = O + (size_t)(row0 + ai * HALF + m * 16) * ldc + col0;
                float o[8];
#pragma unroll
                for (int n = 0; n < 2; ++n)
#pragma unroll
                    for (int j = 0; j < 4; ++j) { const float a = acc[ai][0][m][n][j], b = acc[ai][1][m][n][j]; o[n * 4 + j] = a * fast_sigmoid(a) * b; }
                u32x4 w; w.x = cvt_pk_bf16(o[0], o[1]); w.y = cvt_pk_bf16(o[2], o[3]); w.z = cvt_pk_bf16(o[4], o[5]); w.w = cvt_pk_bf16(o[6], o[7]);
                *(u32x4*)rowp = w; }
    }
};
struct EpiGlu {
    static constexpr bool PERM = true, AFTER_DRAIN = false, CHAIN = false;
    bf16_t* O; const bf16_t* Tin; int ldc; const float* bias;
    __device__ __forceinline__ void operator()(const f32x4 (&acc)[2][2][4][2], const Unit& u, int wr, int wc, int fr, int fq) const {
        const int row0 = u.pm * BM + wr * 64 + fr; const int col0 = u.pn * BM + wc * 32 + 8 * fq;
#pragma unroll
        for (int ai = 0; ai < 2; ++ai)
#pragma unroll
            for (int m = 0; m < 4; ++m) { const size_t ro = (size_t)(row0 + ai * HALF + m * 16) * ldc + col0;
#pragma unroll
                for (int bj = 0; bj < 2; ++bj) { const u32x4 t = *(const u32x4*)(Tin + ro + bj * HALF);
                    const f32x4 b0 = *(const f32x4*)(bias + col0 + bj * HALF), b1 = *(const f32x4*)(bias + col0 + bj * HALF + 4);
                    const f32x4 v0 = acc[ai][bj][m][0] + b0, v1 = acc[ai][bj][m][1] + b1;
                    float o[8];
                    o[0] = bflo(t.x) * fast_sigmoid(v0[0]); o[1] = bfhi(t.x) * fast_sigmoid(v0[1]); o[2] = bflo(t.y) * fast_sigmoid(v0[2]); o[3] = bfhi(t.y) * fast_sigmoid(v0[3]);
                    o[4] = bflo(t.z) * fast_sigmoid(v1[0]); o[5] = bfhi(t.z) * fast_sigmoid(v1[1]); o[6] = bflo(t.w) * fast_sigmoid(v1[2]); o[7] = bfhi(t.w) * fast_sigmoid(v1[3]);
                    u32x4 w; w.x = cvt_pk_bf16(o[0], o[1]); w.y = cvt_pk_bf16(o[2], o[3]); w.z = cvt_pk_bf16(o[4], o[5]); w.w = cvt_pk_bf16(o[6], o[7]);
                    *(u32x4*)(O + ro + bj * HALF) = w; } }
    }
};
struct EpiGate {
    static constexpr bool PERM = true, AFTER_DRAIN = false, CHAIN = false;
    const bf16_t* ZG; int ldz; const float* gate_b; bf16_t* P; bf16_t* MG; int ldc;
    __device__ __forceinline__ void operator()(const f32x4 (&acc)[2][2][4][2], const Unit& u, int wr, int wc, int fr, int fq) const {
        const int row0 = u.pm * BM + wr * 64 + fr; const int col0 = u.pn * BM + wc * 32 + 8 * fq; const int k = u.z;
#pragma unroll
        for (int ai = 0; ai < 2; ++ai)
#pragma unroll
            for (int m = 0; m < 4; ++m) { const int row = row0 + ai * HALF + m * 16;
#pragma unroll
                for (int bj = 0; bj < 2; ++bj) { const int col = col0 + bj * HALF;
                    const u32x4 zg = *(const u32x4*)(ZG + (size_t)row * ldz + k * 2048 + col);
                    const f32x4 g0 = *(const f32x4*)(gate_b + k * 2048 + col), g1 = *(const f32x4*)(gate_b + k * 2048 + col + 4);
                    f32x4 v0, v1;
                    v0[0] = fast_sigmoid(bflo(zg.x) + g0[0]) * acc[ai][bj][m][0][0]; v0[1] = fast_sigmoid(bfhi(zg.x) + g0[1]) * acc[ai][bj][m][0][1];
                    v0[2] = fast_sigmoid(bflo(zg.y) + g0[2]) * acc[ai][bj][m][0][2]; v0[3] = fast_sigmoid(bfhi(zg.y) + g0[3]) * acc[ai][bj][m][0][3];
                    v1[0] = fast_sigmoid(bflo(zg.z) + g1[0]) * acc[ai][bj][m][1][0]; v1[1] = fast_sigmoid(bfhi(zg.z) + g1[1]) * acc[ai][bj][m][1][1];
                    v1[2] = fast_sigmoid(bflo(zg.w) + g1[2]) * acc[ai][bj][m][1][2]; v1[3] = fast_sigmoid(bfhi(zg.w) + g1[3]) * acc[ai][bj][m][1][3];
                    bf16_t* pp = P + (size_t)row * ldc + col;
                    if (k != 0) { const u32x4 pw = *(const u32x4*)pp; v0 += (f32x4){bflo(pw.x), bfhi(pw.x), bflo(pw.y), bfhi(pw.y)}; v1 += (f32x4){bflo(pw.z), bfhi(pw.z), bflo(pw.w), bfhi(pw.w)}; }
                    u32x4 w; w.x = cvt_pk_bf16(v0[0], v0[1]); w.y = cvt_pk_bf16(v0[2], v0[3]); w.z = cvt_pk_bf16(v1[0], v1[1]); w.w = cvt_pk_bf16(v1[2], v1[3]);
                    if (k != 3) *(u32x4*)pp = w; else *(u32x4*)(MG + (size_t)row * ldc + col) = w; } }
    }
};

__device__ __forceinline__ void zero_quad(f32x4& v) { float a, b, c, d; asm volatile("v_mov_b32 %0, 0\n\tv_mov_b32 %1, 0\n\tv_mov_b32 %2, 0\n\tv_mov_b32 %3, 0" : "=v"(a), "=v"(b), "=v"(c), "=v"(d)); v = (f32x4){a, b, c, d}; }
template <class Epi, class Sched, bool ALIGN_EPI = false, bool SP2 = false, int NSEG = 1, int NTS = 0>
__device__ __forceinline__ void gemm_phase(PG8_LAS unsigned char* lds, const Gemm g, const Sched& S, const Epi& E) {
    int tid_ = hw_tid(); asm volatile("" : "+v"(tid_));
    const int tid = tid_, wid = __builtin_amdgcn_readfirstlane(tid >> 6), lane = tid & 63, wr = wid >> 2, wc = wid & 3, fr = lane & 15, fq = lane >> 4;
    const int K = g.K, nt = (NSEG > 1) ? NSEG * NTS : K / BK, ld = g.ld;
    unsigned voffA[2], voffB[2];
#pragma unroll
    for (int i = 0; i < 2; ++i) { int R, C; stage_rc(tid * 16 + i * 8192, R, C); const int Rb = Epi::PERM ? ((R & ~31) + perm32(R & 31)) : R;
        voffA[i] = (unsigned)(R * ld + C) * 2u; voffB[i] = (unsigned)(Rb * ld + C) * 2u; }
    const size_t kstep = (size_t)(BK * 2);
    const size_t hstep = (size_t)HALF * ld * 2;
    const size_t tstep = 2 * hstep;
    const unsigned ldsw = (unsigned)wid * 1024u;
    const int aoff = lds_byte(wr * 64 + fr, fq * 8), boff = lds_byte(wc * 32 + fr, fq * 8);
#define PG8_SA(b, h) (((b) * 2 + (h)) * HTB)
#define PG8_SB(b, h) ((4 + (b) * 2 + (h)) * HTB)
#define PG8_STAGE(bufoff, gbase, voff) do { _Pragma("unroll") for (int _i = 0; _i < 2; ++_i) \
        __builtin_amdgcn_global_load_lds((const unsigned*)((const char*)(gbase) + (voff)[_i]), (PG8_LAS unsigned*)(lds + (bufoff) + ldsw + _i * 8192), 16, 0, 0); } while (0)
#define PG8_LDA(dst, b, h) do { _Pragma("unroll") for (int m = 0; m < 4; ++m) _Pragma("unroll") for (int k = 0; k < 2; ++k) dst[m][k] = *(const PG8_LAS bf16x8*)(lds + PG8_SA(b, h) + aoff + m * 2048 + k * 1024); } while (0)
#define PG8_LDB(dst, b, h) do { _Pragma("unroll") for (int n = 0; n < 2; ++n) _Pragma("unroll") for (int k = 0; k < 2; ++k) dst[n][k] = *(const PG8_LAS bf16x8*)(lds + PG8_SB(b, h) + boff + n * 2048 + k * 1024); } while (0)
#define PG8_MMA(ai, bj, At, Bt) do { __builtin_amdgcn_s_setprio(1); _Pragma("unroll") for (int m = 0; m < 4; ++m) _Pragma("unroll") for (int n = 0; n < 2; ++n) _Pragma("unroll") for (int k = 0; k < 2; ++k) \
        acc[ai][bj][m][n] = __builtin_amdgcn_mfma_f32_16x16x32_bf16(Bt[n][k], At[m][k], acc[ai][bj][m][n], 0, 0, 0); __builtin_amdgcn_s_setprio(0); } while (0)
#define PG8_WAIT_V(n) asm volatile("s_waitcnt vmcnt(" #n ")" ::: "memory")
#define PG8_WAIT_L(n) asm volatile("s_waitcnt lgkmcnt(" #n ")" ::: "memory")
#define PG8_BAR __builtin_amdgcn_s_barrier()
#define PG8_SCHED __builtin_amdgcn_sched_barrier(0)
    Unit cur, nxt; int ui = 0;
    if (!S.next(0, cur)) return;
    f32x4 acc[2][2][4][2];
#pragma unroll
    for (int a = 0; a < 2; ++a)
#pragma unroll
        for (int b = 0; b < 2; ++b)
#pragma unroll
            for (int m = 0; m < 4; ++m)
#pragma unroll
                for (int n = 0; n < 2; ++n) zero_quad(acc[a][b][m][n]);
    bf16x8 At[4][2], B0[2][2], B1[2][2];
    const char* cA = (const char*)g.A + (size_t)cur.z * g.sA + (size_t)cur.pm * tstep; const char* cB = (const char*)g.Bt + (size_t)cur.z * g.sB + (size_t)cur.pn * tstep;
    S.a_ready(cur);
    if constexpr (SP2) {
        PG8_STAGE(PG8_SB(0, 0), cB, voffB); PG8_STAGE(PG8_SB(0, 1), cB + hstep, voffB); PG8_STAGE(PG8_SA(0, 0), cA, voffA); PG8_STAGE(PG8_SA(0, 1), cA + hstep, voffA);
        if (wr == 1) PG8_BAR;
        PG8_WAIT_V(2); PG8_BAR;
        PG8_STAGE(PG8_SB(1, 0), cB + kstep, voffB); PG8_STAGE(PG8_SA(1, 0), cA + kstep, voffA); PG8_STAGE(PG8_SB(1, 1), cB + hstep + kstep, voffB);
        PG8_WAIT_V(6); PG8_BAR;
    } else {
        PG8_STAGE(PG8_SB(0, 0), cB, voffB); PG8_STAGE(PG8_SA(0, 0), cA, voffA); PG8_STAGE(PG8_SB(0, 1), cB + hstep, voffB); PG8_STAGE(PG8_SA(0, 1), cA + hstep, voffA);
        if (wr == 1) PG8_BAR;
        PG8_WAIT_V(4); PG8_BAR;
        PG8_STAGE(PG8_SB(1, 0), cB + kstep, voffB); PG8_STAGE(PG8_SA(1, 0), cA + kstep, voffA); PG8_STAGE(PG8_SB(1, 1), cB + hstep + kstep, voffB);
        PG8_WAIT_V(6); PG8_BAR;
    }
    for (;;) {
        const bool has_next = S.next(ui + 1, nxt);
        const char* nA = has_next ? (const char*)g.A + (size_t)nxt.z * g.sA + (size_t)nxt.pm * tstep : cA; const char* nB = has_next ? (const char*)g.Bt + (size_t)nxt.z * g.sB + (size_t)nxt.pn * tstep : cB;
        for (int t = 0; t < nt; t += 2) {
            const bool last = (t == nt - 2);
            const char* a1; const char* a2; const char* b2;
            if constexpr (NSEG > 1) {
                a1 = cA + (size_t)(t / NTS) * g.sA + (size_t)(t % NTS + 1) * kstep;
                a2 = last ? nA : cA + (size_t)((t + 2) / NTS) * g.sA + (size_t)((t + 2) % NTS) * kstep; b2 = last ? nB : cB + (size_t)((t + 2) / NTS) * g.sB + (size_t)((t + 2) % NTS) * kstep;
            } else {
                a1 = cA + (size_t)(t + 1) * kstep;
                a2 = last ? nA : cA + (size_t)(t + 2) * kstep; b2 = last ? nB : cB + (size_t)(t + 2) * kstep;
            }
            const char* a3 = a2 + kstep; const char* b3 = b2 + kstep;
            if (last && has_next) S.a_ready(nxt);
            if constexpr (SP2) {
            PG8_LDB(B0, 0, 0); PG8_LDB(B1, 0, 1); PG8_SCHED; PG8_LDA(At, 0, 0); PG8_STAGE(PG8_SA(1, 1), a1 + hstep, voffA);
            PG8_WAIT_V(8); PG8_WAIT_L(0); PG8_BAR; PG8_MMA(0, 0, At, B0); PG8_MMA(0, 1, At, B1); PG8_BAR; PG8_SCHED;
            PG8_LDA(At, 0, 1); PG8_STAGE(PG8_SB(0, 0), b2, voffB); PG8_STAGE(PG8_SB(0, 1), b2 + hstep, voffB); PG8_STAGE(PG8_SA(0, 0), a2, voffA);
            PG8_WAIT_V(8); PG8_WAIT_L(0); PG8_BAR; PG8_MMA(1, 0, At, B0); PG8_MMA(1, 1, At, B1); PG8_BAR; PG8_SCHED;
            PG8_LDB(B0, 1, 0); PG8_LDB(B1, 1, 1); PG8_SCHED; PG8_LDA(At, 1, 0); PG8_STAGE(PG8_SA(0, 1), a2 + hstep, voffA);
            PG8_WAIT_V(8); PG8_WAIT_L(0); PG8_BAR; PG8_MMA(0, 0, At, B0); PG8_MMA(0, 1, At, B1); PG8_BAR; PG8_SCHED;
            PG8_LDA(At, 1, 1); PG8_STAGE(PG8_SB(1, 0), b3, voffB); PG8_STAGE(PG8_SB(1, 1), b3 + hstep, voffB); PG8_STAGE(PG8_SA(1, 0), a3, voffA);
            PG8_WAIT_V(8); PG8_WAIT_L(0); PG8_BAR; PG8_MMA(1, 0, At, B0); PG8_MMA(1, 1, At, B1); PG8_BAR; PG8_SCHED;
            } else {
            PG8_LDB(B0, 0, 0); PG8_SCHED; PG8_LDA(At, 0, 0); PG8_STAGE(PG8_SA(1, 1), a1 + hstep, voffA);
            PG8_WAIT_L(8); PG8_BAR; PG8_WAIT_L(0); PG8_MMA(0, 0, At, B0); PG8_BAR; PG8_SCHED;
            PG8_LDB(B1, 0, 1); PG8_STAGE(PG8_SB(0, 0), b2, voffB);
            PG8_BAR; PG8_WAIT_L(0); PG8_MMA(0, 1, At, B1); PG8_BAR;
            PG8_LDA(At, 0, 1); PG8_STAGE(PG8_SA(0, 0), a2, voffA);
            PG8_BAR; PG8_WAIT_L(0); PG8_MMA(1, 0, At, B0); PG8_BAR; PG8_SCHED;
            PG8_STAGE(PG8_SB(0, 1), b2 + hstep, voffB);
            PG8_WAIT_V(6); PG8_BAR; PG8_MMA(1, 1, At, B1); PG8_BAR;
            PG8_LDB(B0, 1, 0); PG8_SCHED; PG8_LDA(At, 1, 0); PG8_STAGE(PG8_SA(0, 1), a2 + hstep, voffA);
            PG8_WAIT_L(8); PG8_BAR; PG8_WAIT_L(0); PG8_MMA(0, 0, At, B0); PG8_BAR; PG8_SCHED;
            PG8_LDB(B1, 1, 1); PG8_STAGE(PG8_SB(1, 0), b3, voffB);
            PG8_BAR; PG8_WAIT_L(0); PG8_MMA(0, 1, At, B1); PG8_BAR;
            PG8_LDA(At, 1, 1); PG8_STAGE(PG8_SA(1, 0), a3, voffA);
            PG8_BAR; PG8_WAIT_L(0); PG8_MMA(1, 0, At, B0); PG8_BAR; PG8_SCHED;
            PG8_STAGE(PG8_SB(1, 1), b3 + hstep, voffB);
            PG8_WAIT_V(6); PG8_BAR; PG8_MMA(1, 1, At, B1); PG8_BAR;
            }
            if constexpr (NSEG > 1) { if (!last && (t + 2) % NTS == 0) { int l3_; asm volatile("v_mbcnt_lo_u32_b32 %0, -1, 0\n\tv_mbcnt_hi_u32_b32 %0, -1, %0" : "=v"(l3_)); E.mid(acc, cur, t / NTS, wr, wc, l3_ & 15, l3_ >> 4); } }
        }
        if constexpr (ALIGN_EPI) { if (wr == 0) PG8_BAR; }
        { int l2_; asm volatile("v_mbcnt_lo_u32_b32 %0, -1, 0\n\tv_mbcnt_hi_u32_b32 %0, -1, %0" : "=v"(l2_)); E(acc, cur, wr, wc, l2_ & 15, l2_ >> 4); }
        S.done(cur);
        if (!has_next) break;
        {
#pragma unroll
        for (int a = 0; a < 2; ++a)
#pragma unroll
            for (int b = 0; b < 2; ++b)
#pragma unroll
                for (int m = 0; m < 4; ++m)
#pragma unroll
                    for (int n = 0; n < 2; ++n) zero_quad(acc[a][b][m][n]);
        }
        cur = nxt; cA = nA; cB = nB; ++ui;
        if constexpr (ALIGN_EPI) { if (wr == 1) PG8_BAR; }
    }
    PG8_WAIT_V(0);
    if constexpr (!ALIGN_EPI) { if (wr == 0) PG8_BAR; }
    PG8_BAR;
#undef PG8_SA
#undef PG8_SB
#undef PG8_STAGE
#undef PG8_LDA
#undef PG8_LDB
#undef PG8_MMA
#undef PG8_WAIT_V
#undef PG8_WAIT_L
#undef PG8_BAR
#undef PG8_SCHED
}
}

namespace att {
constexpr int DQK = 192, DV = 128, KVBLK = 64, QBLK = 32;
constexpr float SCALE = 0.07216878364870322f;
constexpr float THR = 8.f;
constexpr int SHM_V = KVBLK * DV * 2, SHM_K = KVBLK * DQK * 2;
constexpr int ATT_LDS = 2 * SHM_V + 2 * SHM_K + 8 * 64 * 4;
#define KSWZ(row, colB) ((row) * 384 + ((colB) ^ (((row) & 7) << 4)))
#define SBAR() __builtin_amdgcn_sched_barrier(0)
__device__ __forceinline__ int crow(int r, int hi) { return (r & 3) + 8 * (r >> 2) + 4 * hi; }
__device__ __forceinline__ void partialSM(f32x16& p0, f32x16& p1, float& m_reg, float& mn, float& alpha) {
  constexpr float C = SCALE * 1.4426950408889634f;
  float pmax = p0[0];
#pragma unroll
  for (int r = 1; r < 16; ++r) pmax = fmaxf(pmax, p0[r]);
#pragma unroll
  for (int r = 0; r < 16; ++r) pmax = fmaxf(pmax, p1[r]);
  { auto rr = __builtin_amdgcn_permlane32_swap(__float_as_uint(pmax), __float_as_uint(pmax), false, false);
    pmax = fmaxf(__uint_as_float(rr[0]), __uint_as_float(rr[1])); }
  if (__builtin_expect(__all(pmax - m_reg <= THR / SCALE), 1)) { mn = m_reg; alpha = 1.f; }
  else { mn = fmaxf(m_reg, pmax); alpha = __builtin_amdgcn_exp2f((m_reg - mn) * C); m_reg = mn; }
  const float mnC = -mn * C;
#pragma unroll
  for (int r = 0; r < 16; ++r) p0[r] = __builtin_amdgcn_exp2f(fmaf(p0[r], C, mnC));
#pragma unroll
  for (int r = 0; r < 16; ++r) p1[r] = __builtin_amdgcn_exp2f(fmaf(p1[r], C, mnC));
}
__device__ __forceinline__ void finishSM(f32x16& p0, f32x16& p1, float alpha, float& l_reg, bf16x8& pa0, bf16x8& pa1, bf16x8& pa2, bf16x8& pa3) {
  float ps = 0;
#pragma unroll
  for (int r = 0; r < 16; ++r) ps += p0[r];
#pragma unroll
  for (int r = 0; r < 16; ++r) ps += p1[r];
  { auto rr = __builtin_amdgcn_permlane32_swap(__float_as_uint(ps), __float_as_uint(ps), false, false);
    ps = __uint_as_float(rr[0]) + __uint_as_float(rr[1]); }
  l_reg = l_reg * alpha + ps;
#define PK4(P, BASE, OUT) do { unsigned a0 = cvt_pk_bf16(P[BASE + 0], P[BASE + 1]), a1 = cvt_pk_bf16(P[BASE + 2], P[BASE + 3]);   \
    unsigned b0 = cvt_pk_bf16(P[BASE + 4], P[BASE + 5]), b1 = cvt_pk_bf16(P[BASE + 6], P[BASE + 7]);                              \
    auto r0 = __builtin_amdgcn_permlane32_swap(a0, b0, false, false); auto r1 = __builtin_amdgcn_permlane32_swap(a1, b1, false, false); \
    u32x4 w = {r0[0], r1[0], r0[1], r1[1]}; OUT = *reinterpret_cast<bf16x8*>(&w); } while (0)
  PK4(p0, 0, pa0); PK4(p0, 8, pa1); PK4(p1, 0, pa2); PK4(p1, 8, pa3);
#undef PK4
}
__device__ __forceinline__ void qkt(f32x16& p0, f32x16& p1, const char* Ks, const bf16x8* qr, int r32, int hi) {
  p0 = f32x16{}; p1 = f32x16{};
#pragma unroll
  for (int d0 = 0; d0 < 12; ++d0) { const int cb = (d0 * 16 + hi * 8) * 2;
    bf16x8 b0 = *reinterpret_cast<const bf16x8*>(Ks + KSWZ(r32, cb));
    bf16x8 b1 = *reinterpret_cast<const bf16x8*>(Ks + KSWZ(32 + r32, cb));
    p0 = __builtin_amdgcn_mfma_f32_32x32x16_bf16(b0, qr[d0], p0, 0, 0, 0);
    p1 = __builtin_amdgcn_mfma_f32_32x32x16_bf16(b1, qr[d0], p1, 0, 0, 0); }
}
__device__ __forceinline__ int v_st(int k, int c) { const int kk = (k & ~0xC) | ((k & 4) << 1) | ((k & 8) >> 1); return ((kk >> 3) * 4 + (c >> 5)) * 512 + ((kk & 7) * 32 + (c & 31)) * 2; }
__device__ __forceinline__ int v_rd_base(int lane) { return ((lane & 3) << 3) | (((lane >> 2) & 3) << 6) | (((lane >> 4) & 1) << 5) | (((lane >> 5) & 1) << 8); }
constexpr int v_rd_off(int d0, int ks, int half) { return d0 * 512 + ks * 4096 + half * 2048; }
template <int OFF> __device__ __forceinline__ s16x4 tr_read(int vb) {
  s16x4 r; asm volatile("ds_read_b64_tr_b16 %0, %1 offset:%2" : "=&v"(r) : "v"(vb), "i"(OFF) : "memory"); return r;
}
template <int D0> __device__ __forceinline__ void pv_one(f32x16& od, int vb, bf16x8 pa0, bf16x8 pa1, bf16x8 pa2, bf16x8 pa3) {
  const s16x4 l0 = tr_read<v_rd_off(D0, 0, 0)>(vb), h0 = tr_read<v_rd_off(D0, 0, 1)>(vb), l1 = tr_read<v_rd_off(D0, 1, 0)>(vb), h1 = tr_read<v_rd_off(D0, 1, 1)>(vb);
  const s16x4 l2 = tr_read<v_rd_off(D0, 2, 0)>(vb), h2 = tr_read<v_rd_off(D0, 2, 1)>(vb), l3 = tr_read<v_rd_off(D0, 3, 0)>(vb), h3 = tr_read<v_rd_off(D0, 3, 1)>(vb);
  asm volatile("s_waitcnt lgkmcnt(0)" ::: "memory"); SBAR();
#define PK(L, H) (bf16x8){L[0], L[1], L[2], L[3], H[0], H[1], H[2], H[3]}
  od = __builtin_amdgcn_mfma_f32_32x32x16_bf16(pa0, PK(l0, h0), od, 0, 0, 0);
  od = __builtin_amdgcn_mfma_f32_32x32x16_bf16(pa1, PK(l1, h1), od, 0, 0, 0);
  od = __builtin_amdgcn_mfma_f32_32x32x16_bf16(pa2, PK(l2, h2), od, 0, 0, 0);
  od = __builtin_amdgcn_mfma_f32_32x32x16_bf16(pa3, PK(l3, h3), od, 0, 0, 0);
#undef PK
}
__device__ __forceinline__ void attn_unit(const bf16* __restrict__ Qb, const bf16* __restrict__ Kh, const bf16* __restrict__ Vh, bf16* __restrict__ Ob, int ldo, int seq, char* lds) {
  int tid_ = hw_tid(); asm volatile("" : "+v"(tid_));
  const int tid = tid_, wid = tid >> 6, lane = tid & 63, r32 = lane & 31, hi = lane >> 5;
  char* V_lds = lds; char* K_lds = lds + 2 * SHM_V;
  float* ws = (float*)(lds + 2 * SHM_V + 2 * SHM_K) + wid * 64; float* li_l = ws; float* al_l = ws + 32;
  float m_reg = -1e30f, l_reg = 0; f32x16 o[4] = {}; bf16x8 qr[12];
  const bf16* Qw = Qb + (long)(wid * QBLK + r32) * DQK + hi * 8;
#pragma unroll
  for (int d0 = 0; d0 < 12; ++d0) qr[d0] = *reinterpret_cast<const bf16x8*>(Qw + d0 * 16);
  const int sr = tid >> 4, sc = (tid & 15) * 8, vst0 = v_st(sr, sc), vst1 = v_st(32 + sr, sc);
  int kst[3];
#pragma unroll
  for (int i = 0; i < 3; ++i) { const int id = tid + 512 * i; kst[i] = KSWZ(id / 24, (id % 24) * 16); }
  const int vb0 = (int)(uintptr_t)V_lds + v_rd_base(lane);
  bf16x8 vs0, vs1, ks0, ks1, ks2;
#define SLOAD(k0) do { vs0 = *reinterpret_cast<const bf16x8*>(&Vh[(long)((k0) + sr) * DV + sc]); vs1 = *reinterpret_cast<const bf16x8*>(&Vh[(long)((k0) + 32 + sr) * DV + sc]); \
    const bf16* kt_ = Kh + (long)(k0) * DQK; ks0 = *reinterpret_cast<const bf16x8*>(kt_ + (long)tid * 8); ks1 = *reinterpret_cast<const bf16x8*>(kt_ + (long)(tid + 512) * 8); ks2 = *reinterpret_cast<const bf16x8*>(kt_ + (long)(tid + 1024) * 8); } while (0)
#define SWRITE(b) do { *(bf16x8*)(V_lds + (b) * SHM_V + vst0) = vs0; *(bf16x8*)(V_lds + (b) * SHM_V + vst1) = vs1; \
    *(bf16x8*)(K_lds + (b) * SHM_K + kst[0]) = ks0; *(bf16x8*)(K_lds + (b) * SHM_K + kst[1]) = ks1; *(bf16x8*)(K_lds + (b) * SHM_K + kst[2]) = ks2; } while (0)
#define RESC(a) do { if (__any((a) < 1.f)) { if (hi == 0) al_l[r32] = (a); asm volatile("s_waitcnt lgkmcnt(0)" ::: "memory"); \
    _Pragma("unroll") for (int d = 0; d < 4; ++d) _Pragma("unroll") for (int r = 0; r < 16; ++r) o[d][r] *= al_l[crow(r, hi)]; } } while (0)
  f32x16 p0, p1; float mn, al; bf16x8 pa0, pa1, pa2, pa3; const int NT = seq / KVBLK;
  __syncthreads();
  SLOAD(0); asm volatile("s_waitcnt vmcnt(0)" ::: "memory"); SWRITE(0); __syncthreads();
  for (int j = 0; j < NT; ++j) {
    const int b = j & 1;
    if (j + 1 < NT) SLOAD((j + 1) * KVBLK);
    SBAR(); qkt(p0, p1, K_lds + b * SHM_K, qr, r32, hi);
    partialSM(p0, p1, m_reg, mn, al);
    RESC(al);
    finishSM(p0, p1, al, l_reg, pa0, pa1, pa2, pa3); SBAR();
    const int vb = vb0 + b * SHM_V;
    pv_one<0>(o[0], vb, pa0, pa1, pa2, pa3); pv_one<1>(o[1], vb, pa0, pa1, pa2, pa3); pv_one<2>(o[2], vb, pa0, pa1, pa2, pa3); pv_one<3>(o[3], vb, pa0, pa1, pa2, pa3);
    if (j + 1 < NT) { asm volatile("s_waitcnt vmcnt(0)" ::: "memory"); SWRITE(b ^ 1); }
    __syncthreads();
  }
  if (hi == 0) li_l[r32] = l_reg; asm volatile("s_waitcnt lgkmcnt(0)" ::: "memory");
  float rli[16];
#pragma unroll
  for (int r = 0; r < 16; ++r) rli[r] = __builtin_amdgcn_rcpf(li_l[crow(r, hi)]);
  bf16* Ow = Ob + (long)(wid * QBLK) * ldo;
#pragma unroll
  for (int r = 0; r < 16; ++r) { const int orow = crow(r, hi);
#pragma unroll
    for (int d0 = 0; d0 < 4; ++d0) Ow[(long)orow * ldo + d0 * 32 + r32] = (bf16)(cvt_pk_bf16(o[d0][r] * rli[r], 0.f) & 0xffffu); }
#undef SLOAD
#undef SWRITE
#undef RESC
}
}

constexpr int DM = 2048, NBATCH = 4, TL = 4096, NLAYER = 4, TCX = 256, DFF = 5632, BW = 512;
constexpr int M_LAT = NBATCH * TL, M_CTX = NBATCH * TCX, MT = M_LAT + M_CTX;
constexpr int N_IN_W = 12864;
constexpr int NZW = 13056;
constexpr int ZP = 4864;
constexpr int Z_CKV = 768, Z_KR = 1280, Z_RW = 1344, Z_S5 = 3136, Z_LX = 3648, Z_LG = 4160, Z_PAD = 4672, Z_G = 4864;
constexpr int NKEY = TL + TCX;
constexpr int NWAVES = 8;
constexpr float NORM_EPS = 1e-6f;
constexpr int LDS_BYTES = 147456, MISC_OFF = 131072 + 320;

enum { I_X = 0, I_C, I_CTX, I_CCTX, I_ADAW, I_ADAB, I_NORMW, I_W1, I_W3, I_W2, I_WIN, I_GATEB, I_QNORM, I_WUQ, I_KVNORM, I_WUKV,
       I_MU, I_W0, I_RW2, I_A0, I_A2, I_G2, I_KK, I_KA, I_RK, I_LNW, I_LNB, I_LAMRE, I_LAMIM, I_LOGDT, I_BRE, I_BIM, I_CRE, I_CIM, I_S5D, I_GLUW, I_GLUB,
       I_CONVW, I_CONVB, I_WA, I_BA, I_WX, I_BX, I_LAM, I_WBR, I_WOUT, N_INPUTS };

constexpr size_t SZ(size_t rows, size_t cols, size_t b) { return rows * cols * b; }
constexpr size_t WS_CTL = 0, CTL_BYTES = 1u << 20;
constexpr size_t WS_MOD = CTL_BYTES;
constexpr size_t WS_XR = WS_MOD + 1572864;
constexpr size_t WS_H = WS_XR + SZ(MT, DM, 4);
constexpr size_t WS_Y = WS_H + SZ(MT, DM, 2);
constexpr size_t WS_W13 = WS_Y + SZ(MT, DM, 2);
constexpr size_t WS_W2 = WS_W13 + 2 * SZ(11264, 2048, 2);
constexpr size_t WS_WIN = WS_W2 + 2 * SZ(2048, 5632, 2);
constexpr size_t WS_WUQ = WS_WIN + SZ(NZW, 2048, 2);
constexpr size_t WS_WUKV = WS_WUQ + SZ(768, 768, 2);
constexpr size_t WS_WBR = WS_WUKV + SZ(1024, 512, 2);
constexpr size_t WS_WOUT = WS_WBR + 4 * SZ(2048, 512, 2);
constexpr size_t WS_WGLU = WS_WOUT + SZ(2048, 2048, 2);
constexpr size_t WS_WLORA = WS_WGLU + SZ(512, 512, 2);
constexpr size_t WS_WLRU = WS_WLORA + SZ(2560, 256, 2);
constexpr size_t WS_Z = WS_WLRU + SZ(2048, 512, 2);
constexpr size_t WS_GZ = WS_Z + SZ(MT, ZP, 2);
constexpr size_t WS_R1 = WS_GZ + SZ(MT, 8192, 2);
constexpr size_t WS_U = WS_R1;
constexpr size_t WS_PREP = WS_R1;
constexpr size_t WS_CQN = WS_R1;
constexpr size_t WS_CKVN = WS_CQN + SZ(MT, 768, 2);
constexpr size_t WS_LIN = WS_CKVN + SZ(MT, 512, 2);
constexpr size_t WS_XCVB = WS_LIN + SZ(MT, 256, 2);
constexpr size_t WS_RWKB = WS_XCVB + SZ(MT, 512, 2);
constexpr size_t WS_R1E = WS_RWKB + SZ(MT, 512, 2);
constexpr size_t WS_R2 = (WS_R1E - WS_R1 >= SZ(MT, DFF, 2)) ? WS_R1E : WS_R1 + SZ(MT, DFF, 2);
constexpr size_t WS_QB = WS_R2;
constexpr size_t WS_QC = WS_QB + SZ(16 * TL, 192, 2);
constexpr size_t WS_KB = WS_QC + SZ(16 * TCX, 192, 2);
constexpr size_t WS_VB = WS_KB + SZ(16 * NKEY, 192, 2);
constexpr size_t RWS = SZ(MT, BW, 4);
constexpr size_t RWSB = SZ(MT, BW, 2);
constexpr size_t WS_RWW = WS_VB + SZ(16 * NKEY, 128, 2);
constexpr size_t WS_RWB = WS_RWW + 2 * RWS;
constexpr size_t WS_G = WS_RWB + 7 * RWSB;
constexpr size_t WS_PACC = WS_G + RWSB;
constexpr size_t WS_RWY = WS_PACC + SZ(MT, DM, 4);
constexpr size_t WS_LRA = WS_RWY + 2 * RWS;
constexpr size_t WS_LRB = WS_LRA + 2 * RWS;
constexpr size_t WS_S5Y = WS_LRB + 2 * RWS;
constexpr size_t WS_TG = WS_S5Y + 2 * RWS;
constexpr size_t WS_YS = WS_TG + SZ(MT, BW, 2);
constexpr size_t WS_MG = WS_YS + 4 * SZ(MT, BW, 2);
constexpr size_t WS_LRH = WS_MG + SZ(MT, DM, 2);
constexpr size_t WS_YP = WS_LRH + 2 * RWS;
constexpr size_t WS_ROPE = WS_YP + 4 * SZ(M_CTX, DM, 2);
constexpr size_t WS_LRUSP = WS_ROPE + SZ(TL, 64, 4);
constexpr size_t WS_S5D = WS_LRUSP + 4 * 4096;
constexpr size_t WS_NV = WS_S5D + SZ(4 * 2 * 32 * 64, 4, 4);
constexpr size_t WS_WSET2 = WS_NV + SZ(38 * 5, DM, 4);
constexpr size_t WSET_BYTES = WS_Z - WS_W13;
constexpr size_t WS_END = WS_WSET2 + WSET_BYTES;
__device__ __forceinline__ size_t wset_off(int set) { return set ? (WS_WSET2 - WS_W13) : 0; }
constexpr int CW_BAR = 4096, CW_Q = 16384;

#define XB_TMO      128
#define XB_XCNT(j)  (256  + 64 * (j))
#define XB_XSUB(j)  (1280 + 64 * (j))
#define XB_XGEN(j)  (2304 + 64 * (j))
#define XB_TOP      3328
#define XB_TOPGEN   3392
#define XCD_BAR_WORDS 3456
#define XB_SPIN_CAP (1u << 22)
__device__ __forceinline__ unsigned xb_ld(unsigned* p)              { return __hip_atomic_load(p, __ATOMIC_RELAXED, __HIP_MEMORY_SCOPE_AGENT); }
__device__ __forceinline__ unsigned xb_add(unsigned* p, unsigned v) { return __hip_atomic_fetch_add(p, v, __ATOMIC_RELAXED, __HIP_MEMORY_SCOPE_AGENT); }
__device__ __forceinline__ unsigned xb_xcc_id() { return (unsigned)__builtin_amdgcn_s_getreg((3 << 11) | 20) & 0xFu; }
#define XB_SPIN(cond, bar) do { unsigned _sp = 0; while (cond) { __builtin_amdgcn_s_sleep(1); \
    if ((++_sp & 255u) == 0u) { if (xb_ld(&(bar)[XB_TMO])) break; if (_sp > XB_SPIN_CAP) { atomicAdd(&(bar)[XB_TMO], 1u); break; } } } } while (0)
struct XcdBarrier { unsigned* bar; unsigned x; volatile LAS unsigned* st; };
__device__ __forceinline__ XcdBarrier xcd_barrier_post(unsigned* bar, volatile LAS unsigned* st) {
    XcdBarrier b; b.bar = bar; b.x = xb_xcc_id(); b.st = st;
    if (hw_tid() == 0) (void)xb_add(&bar[XB_XCNT(b.x)], 1u);
    return b;
}
__device__ __forceinline__ void xcd_barrier_complete(unsigned* bar, unsigned x, unsigned& nloc, unsigned& nx) {
    const unsigned G = gridDim.x * gridDim.y * gridDim.z;
    unsigned sum, cnt, mine, sp = 0u;
    for (;;) {
        sum = 0u; cnt = 0u; mine = 0u;
#pragma unroll
        for (unsigned j = 0; j < 16; ++j) { const unsigned c = xb_ld(&bar[XB_XCNT(j)]); sum += c; cnt += (c > 0u) ? 1u : 0u; }
        mine = xb_ld(&bar[XB_XCNT(x)]);
        if (sum == G) { mine = xb_ld(&bar[XB_XCNT(x)]); break; }
        __builtin_amdgcn_s_sleep(1);
        if ((++sp & 255u) == 0u) { if (xb_ld(&bar[XB_TMO])) break; if (sp > XB_SPIN_CAP) { atomicAdd(&bar[XB_TMO], 1u); break; } }
    }
    nloc = mine > 0u ? mine : 1u; nx = cnt > 0u ? cnt : 1u;
}
__device__ __forceinline__ void xcd_barrier(const XcdBarrier& b) {
    asm volatile("s_waitcnt vmcnt(0)" ::: "memory");
    __syncthreads();
    if (hw_tid() == 0) {
        unsigned* bar = b.bar; unsigned bx = b.x; asm volatile("" : "+s"(bar), "+s"(bx));
        __builtin_amdgcn_s_waitcnt(0);
        unsigned nloc = b.st[0], nx = b.st[1];
        if (nloc == 0u) { xcd_barrier_complete(bar, bx, nloc, nx); b.st[0] = nloc; b.st[1] = nx; }
        const unsigned old = xb_add(&bar[XB_XSUB(bx)], 1u);
        const unsigned gen = old / nloc;
        if (old + 1u == (gen + 1u) * nloc) {
            __builtin_amdgcn_fence(__ATOMIC_RELEASE, "agent");
            asm volatile("s_waitcnt vmcnt(0)" ::: "memory");
            const unsigned og = xb_add(&bar[XB_TOP], 1u);
            const unsigned tg = og / nx;
            if (og + 1u == (tg + 1u) * nx) xb_add(&bar[XB_TOPGEN], 1u);
            else XB_SPIN(xb_ld(&bar[XB_TOPGEN]) == tg, bar);
            __builtin_amdgcn_fence(__ATOMIC_ACQUIRE, "agent");
            xb_add(&bar[XB_XGEN(bx)], 1u);
            asm volatile("s_waitcnt vmcnt(0)" ::: "memory");
        } else {
            XB_SPIN(xb_ld(&bar[XB_XGEN(bx)]) == gen, bar);
            __builtin_amdgcn_fence(__ATOMIC_ACQUIRE, "agent");
            asm volatile("s_waitcnt vmcnt(0)" ::: "memory");
        }
    }
    __syncthreads();
}

struct KArgs { const float* in[N_INPUTS]; float* out; unsigned char* ws; int ph_lo, ph_hi; };
typedef const __attribute__((address_space(4))) KArgs* KP;
#define LAUNDER_A() KP a = a_in_; asm volatile("" : "+s"(a))
#define LDS_WAIT() asm volatile("s_waitcnt lgkmcnt(0)" ::: "memory")
#define PHASE_IDS() LAUNDER_A(); int tid_ = hw_tid(); asm volatile("" : "+v"(tid_)); int bx_ = blockIdx.x; int gdx_ = gridDim.x; asm volatile("" : "+s"(bx_), "+s"(gdx_)); \
    const int tid = tid_, lane = tid & 63, wave = __builtin_amdgcn_readfirstlane(tid >> 6), gw = bx_ * NWAVES + wave, NGW = gdx_ * NWAVES; (void)tid; (void)lane; (void)wave; (void)gw; (void)NGW
__device__ __forceinline__ float dpp_x(float v, int ctrl) { return 0.f; }
#define DPP_ADD(v, ctrl) v += __builtin_bit_cast(float, __builtin_amdgcn_update_dpp(0, __builtin_bit_cast(int, v), ctrl, 0xF, 0xF, true))
__device__ __forceinline__ float sum8(float v) { DPP_ADD(v, 0xB1); DPP_ADD(v, 0x4E); DPP_ADD(v, 0x141); return v; }
__device__ __forceinline__ float wave_sum(float v) {
    DPP_ADD(v, 0xB1); DPP_ADD(v, 0x4E); DPP_ADD(v, 0x141); DPP_ADD(v, 0x140);
    const int i = __builtin_bit_cast(int, v);
    return (__builtin_bit_cast(float, __builtin_amdgcn_readlane(i, 0)) + __builtin_bit_cast(float, __builtin_amdgcn_readlane(i, 16))) + (__builtin_bit_cast(float, __builtin_amdgcn_readlane(i, 32)) + __builtin_bit_cast(float, __builtin_amdgcn_readlane(i, 48)));
}
__device__ __forceinline__ void ld8bf(const bf16* p, float (&f)[8]) { const u32x4 v = *(const u32x4*)p; f[0] = bflo(v.x); f[1] = bfhi(v.x); f[2] = bflo(v.y); f[3] = bfhi(v.y); f[4] = bflo(v.z); f[5] = bfhi(v.z); f[6] = bflo(v.w); f[7] = bfhi(v.w); }
__device__ __forceinline__ void st8bf(bf16* p, const float (&f)[8]) { u32x4 w; w.x = cvt_pk_bf16(f[0], f[1]); w.y = cvt_pk_bf16(f[2], f[3]); w.z = cvt_pk_bf16(f[4], f[5]); w.w = cvt_pk_bf16(f[6], f[7]); *(u32x4*)p = w; }
__device__ __forceinline__ void ld8f(const float* p, float (&f)[8]) { const f32x4 a = *(const f32x4*)p, b = *(const f32x4*)(p + 4); f[0] = a[0]; f[1] = a[1]; f[2] = a[2]; f[3] = a[3]; f[4] = b[0]; f[5] = b[1]; f[6] = b[2]; f[7] = b[3]; }
__device__ __forceinline__ void st8f(float* p, const float (&f)[8]) { *(f32x4*)p = (f32x4){f[0], f[1], f[2], f[3]}; *(f32x4*)(p + 4) = (f32x4){f[4], f[5], f[6], f[7]}; }
__device__ __forceinline__ int mod_idx(int row) { return row < M_LAT ? (row >> 12) : 4; }
__device__ __forceinline__ const float* modp(KP a, int l, int s, int j) { return (const float*)(a->ws + WS_MOD) + ((size_t)(l * 5 + s) * 9 + j) * DM; }
__device__ __forceinline__ int scan_row(int s, int d, int b) {
    if (s < TCX) { const int t = d ? (TCX - 1 - s) : s; return M_LAT + b * TCX + t; }
    const int u = s - TCX; const int t = d ? (TL - 1 - u) : u; return b * TL + t;
}
constexpr int NSTEP = TCX + TL;

struct TItem { const float* src; bf16* dst; int N, ldt; };
__device__ __forceinline__ void titem_load(const TItem& t, f32x4 (&v)[8], int lane) {
#pragma unroll
    for (int i = 0; i < 8; ++i) v[i] = __builtin_nontemporal_load((const f32x4*)(t.src + (size_t)((lane >> 3) + 8 * i) * t.N + (lane & 7) * 4));
}
__device__ __forceinline__ void titem_to_lds(const f32x4 (&v)[8], LAS float* scr, int lane) {
#pragma unroll
    for (int i = 0; i < 8; ++i) { LAS float* d = scr + ((lane >> 3) + 8 * i) * 33 + (lane & 7) * 4; d[0] = v[i][0]; d[1] = v[i][1]; d[2] = v[i][2]; d[3] = v[i][3]; }
    LDS_WAIT(); asm volatile("" ::: "memory");
}
__device__ __forceinline__ void titem_from_lds(const TItem& t, LAS float* scr, int lane) {
    const int c = lane & 7;
#pragma unroll
    for (int j = 0; j < 4; ++j) { const int n = (lane >> 3) + 8 * j; const LAS float* s = scr + (8 * c) * 33 + n;
        u32x4 o; o.x = cvt_pk_bf16(s[0 * 33], s[1 * 33]); o.y = cvt_pk_bf16(s[2 * 33], s[3 * 33]); o.z = cvt_pk_bf16(s[4 * 33], s[5 * 33]); o.w = cvt_pk_bf16(s[6 * 33], s[7 * 33]);
        __builtin_nontemporal_store(o, (u32x4*)(t.dst + (size_t)n * t.ldt + 8 * c)); }
    LDS_WAIT(); asm volatile("" ::: "memory");
}
constexpr int CV_13 = 32 * 176, CV_2 = 88 * 64, CV_IN = 32 * 402, CV_UQ = 12 * 24, CV_UKV = 8 * 32, CV_BR = 8 * 64, CV_OUT = 32 * 64, CV_GLU = 8 * 16;
constexpr int CV_NITEMS = 4 * CV_13 + 2 * CV_2 + CV_IN + CV_UQ + CV_UKV + 4 * CV_BR + CV_OUT + CV_GLU;
__device__ __forceinline__ void titem_decode(KP a, int l, unsigned char* ws, int it, TItem& t) {
    int r = it; const float* W; bf16* WT; int N, ldt, k0, n0, drow0;
    if (r < 4 * CV_13) { const int mi = r / CV_13; r -= mi * CV_13; const int s = mi >> 1, is3 = mi & 1, kb = r / 176, nb = r % 176; n0 = 32 * nb; k0 = 64 * kb;
        W = a->in[is3 ? I_W3 : I_W1] + (size_t)(l * 2 + s) * DM * DFF; N = DFF; WT = (bf16*)(ws + WS_W13) + (size_t)s * 11264 * 2048; ldt = 2048; drow0 = (n0 >> 7) * 256 + (n0 & 127) + is3 * 128; }
    else if ((r -= 4 * CV_13) < 2 * CV_2) { const int s = r / CV_2; r -= s * CV_2; const int kb = r / 64, nb = r % 64; n0 = 32 * nb; k0 = 64 * kb;
        W = a->in[I_W2] + (size_t)(l * 2 + s) * DFF * DM; N = DM; WT = (bf16*)(ws + WS_W2) + (size_t)s * 2048 * 5632; ldt = 5632; drow0 = n0; }
    else if ((r -= 2 * CV_2) < CV_IN) { const int kb = r / 402, nb = r % 402; n0 = 32 * nb; k0 = 64 * kb;
        W = a->in[I_WIN] + (size_t)l * DM * N_IN_W; N = N_IN_W; WT = (bf16*)(ws + WS_WIN); ldt = 2048; drow0 = n0 < Z_PAD ? n0 : n0 + (Z_G - Z_PAD); }
    else if ((r -= CV_IN) < CV_UQ) { const int kb = r / 24, nb = r % 24; n0 = 32 * nb; k0 = 64 * kb;
        W = a->in[I_WUQ] + (size_t)l * 768 * 768; N = 768; WT = (bf16*)(ws + WS_WUQ); ldt = 768; drow0 = n0; }
    else if ((r -= CV_UQ) < CV_UKV) { const int kb = r / 32, nb = r % 32; n0 = 32 * nb; k0 = 64 * kb;
        W = a->in[I_WUKV] + (size_t)l * 512 * 1024; N = 1024; WT = (bf16*)(ws + WS_WUKV); ldt = 512; drow0 = n0; }
    else if ((r -= CV_UKV) < 4 * CV_BR) { const int k = r / CV_BR; r -= k * CV_BR; const int kb = r / 64, nb = r % 64; n0 = 32 * nb; k0 = 64 * kb;
        W = a->in[I_WBR] + (size_t)(l * 4 + k) * 512 * 2048; N = 2048; WT = (bf16*)(ws + WS_WBR) + (size_t)k * 2048 * 512; ldt = 512; drow0 = n0; }
    else if ((r -= 4 * CV_BR) < CV_OUT) { const int kb = r / 64, nb = r % 64; n0 = 32 * nb; k0 = 64 * kb;
        W = a->in[I_WOUT] + (size_t)l * 2048 * 2048; N = 2048; WT = (bf16*)(ws + WS_WOUT); ldt = 2048; drow0 = n0; }
    else { r -= CV_OUT; const int kb = r / 16, nb = r % 16; n0 = 32 * nb; k0 = 64 * kb;
        W = a->in[I_GLUW] + (size_t)l * 512 * 512; N = 512; WT = (bf16*)(ws + WS_WGLU); ldt = 512; drow0 = n0; }
    t.src = W + (size_t)k0 * N + n0; t.dst = WT + (size_t)drow0 * ldt + k0; t.N = N; t.ldt = ldt;
}
__device__ __forceinline__ void convert_wave(KP a, int l, LAS float* scr, int gw_, int NGW_, int lane) {
#define gw gw_
#define NGW NGW_
    unsigned char* ws = a->ws + wset_off(l & 1);
    if (gw < CV_NITEMS) {
        TItem cur, nxt; f32x4 vc[8], vn[8]; int it = gw;
        titem_decode(a, l, ws, it, cur); titem_load(cur, vc, lane);
        bool h1 = it + NGW < CV_NITEMS; nxt = cur;
#pragma unroll
        for (int i = 0; i < 8; ++i) vn[i] = vc[i];
        if (h1) { titem_decode(a, l, ws, it + NGW, nxt); titem_load(nxt, vn, lane); }
        for (;;) {
            titem_to_lds(vc, scr, lane);
            const int it2 = it + 2 * NGW; const bool h2 = h1 && it2 < CV_NITEMS;
            TItem n2 = nxt;
            if (h2) { titem_decode(a, l, ws, it2, n2); titem_load(n2, vc, lane); }
            titem_from_lds(cur, scr, lane);
            if (!h1) break;
#pragma unroll
            for (int i = 0; i < 8; ++i) { const f32x4 t_ = vn[i]; vn[i] = vc[i]; vc[i] = t_; }
            cur = nxt; nxt = n2; h1 = h2; it += NGW;
        }
    }
    const int gt = gw * 64 + lane, NGT = NGW * 64;
    for (int e = gt; e < (Z_G - Z_PAD) * 256; e += NGT) { unsigned z_ = 0u; asm volatile("" : "+v"(z_)); *(u32x4*)((bf16*)(ws + WS_WIN) + (size_t)Z_PAD * 2048 + (size_t)e * 8) = (u32x4){z_, z_, z_, z_}; }
    for (int e = gt; e < 2560 * 32; e += NGT) {
        const int n = e % 2560, j = e / 2560, k0 = 8 * j, seg = n >> 9, c = n & 511; float f[8];
        const float* src = nullptr;
        if (seg < 2) { if (k0 < 64) src = a->in[I_RW2] + ((size_t)(l * 2 + seg) * 64 + k0) * 512 + c; }
        else if (seg < 4) { if (k0 >= 64 && k0 < 128) src = a->in[I_A2] + ((size_t)(l * 2 + seg - 2) * 64 + (k0 - 64)) * 512 + c; }
        else { if (k0 >= 128) src = a->in[I_G2] + ((size_t)l * 128 + (k0 - 128)) * 512 + c; }
#pragma unroll
        for (int q = 0; q < 8; ++q) f[q] = src ? src[(size_t)q * 512] : 0.f;
        st8bf((bf16*)(ws + WS_WLORA) + (size_t)n * 256 + k0, f);
    }
    for (int e = gt; e < 2048 * 64; e += NGT) {
        const int n = e % 2048, j = e / 2048, k0 = 8 * j, pn = n >> 8, rr = n & 255, isx = rr >> 7, c = (pn & 3) * 128 + (rr & 127), blk = c >> 6, kk = c & 63, d = pn >> 2; float f[8];
        const float* Wsel = a->in[isx ? I_WX : I_WA];
        const bool nz = (k0 >> 6) == blk;
        const float* src = Wsel + ((size_t)((l * 2 + d) * 8 + blk) * 64 + (k0 & 63)) * 64 + kk;
#pragma unroll
        for (int q = 0; q < 8; ++q) f[q] = nz ? src[(size_t)q * 64] : 0.f;
        st8bf((bf16*)(ws + WS_WLRU) + (size_t)n * 512 + k0, f);
    }
#undef gw
#undef NGW
}
__device__ __forceinline__ void convert_weights(KP a_in_, int l, LAS unsigned char* ldsb, int vg, int nvg) {
    PHASE_IDS();
    convert_wave(a, l, (LAS float*)(ldsb + wave * 16384), vg * NWAVES + wave, nvg * NWAVES, lane);
}
__device__ __forceinline__ void tables_phase(KP a_in_) {
    PHASE_IDS();
    unsigned char* ws = a->ws; const int gt = gw * 64 + lane, NGT = NGW * 64;
    for (int e = gt; e < TL * 32; e += NGT) { const int t = e >> 5, i = e & 31; const float inv = powf(10000.0f, -(float)(i & 15) * (1.0f / 16.0f)); const float pos = (float)(i < 16 ? (t >> 6) : (t & 63));
        float sn, co; sincosf(pos * inv, &sn, &co); float* rp = (float*)(ws + WS_ROPE) + (size_t)t * 64; rp[i] = co; rp[32 + i] = sn; }
    for (int e = gt; e < NLAYER * 1024; e += NGT) { const float x = -a->in[I_LAM][e]; ((float*)(ws + WS_LRUSP))[e] = -8.0f * 1.4426950408889634f * (fmaxf(x, 0.f) + log1pf(expf(-fabsf(x)))); }
    for (int e = gt; e < NLAYER * 2 * 32 * 64; e += NGT) { const int gi = e >> 6;
        const float lre = fminf(a->in[I_LAMRE][e], -1e-4f), lim = a->in[I_LAMIM][e], dt = expf(a->in[I_LOGDT][gi]);
        const float mag = expf(lre * dt); float sn, co; sincosf(lim * dt, &sn, &co); const float ar = mag * co, ai = mag * sn;
        const float den = lre * lre + lim * lim, nr = ar - 1.0f, ni = ai;
        *(f32x4*)((float*)(ws + WS_S5D) + (size_t)e * 4) = (f32x4){ar, ai, (nr * lre + ni * lim) / den, (ni * lre - nr * lim) / den}; }
}
__device__ __forceinline__ void mod_phase(KP a_in_, LAS unsigned char* ldsb) {
    PHASE_IDS();
    LAS float* sl = (LAS float*)ldsb;
    LAS float* part = (LAS float*)(ldsb + 40960);
    for (int i = tid; i < 5 * DM; i += 512) { const int s = i / DM, k = i - s * DM; const float c = s < 4 ? a->in[I_C][s * DM + k] : a->in[I_CCTX][k]; sl[i] = c / (1.0f + expf(-c)); }
    __syncthreads();
    for (int u = bx_; u < NLAYER * 72; u += gdx_) {
        const int l = u / 72, cb = u % 72;
        const float* Wp = a->in[I_ADAW] + (size_t)l * DM * 18432 + cb * 256 + 4 * lane;
        f32x4 acc[5];
#pragma unroll
        for (int s = 0; s < 5; ++s) acc[s] = (f32x4){0.f, 0.f, 0.f, 0.f};
        const int kbeg = wave * 256;
#pragma unroll 8
        for (int k = kbeg; k < kbeg + 256; ++k) { const f32x4 w = __builtin_nontemporal_load((const f32x4*)(Wp + (size_t)k * 18432));
#pragma unroll
            for (int s = 0; s < 5; ++s) acc[s] += w * sl[s * DM + k]; }
#pragma unroll
        for (int s = 0; s < 5; ++s) *(LAS f32x4*)(part + (wave * 5 + s) * 256 + 4 * lane) = acc[s];
        __syncthreads();
        for (int o = tid; o < 5 * 256; o += 512) { const int s = o >> 8, c = o & 255; float v = a->in[I_ADAB][(size_t)l * 18432 + cb * 256 + c];
#pragma unroll
            for (int w = 0; w < 8; ++w) v += part[(w * 5 + s) * 256 + c];
            ((float*)(a->ws + WS_MOD))[(size_t)(l * 5 + s) * 18432 + cb * 256 + c] = v; }
        __syncthreads();
    }
}

constexpr int NV_T = 1 + NLAYER * 3;
__device__ __forceinline__ void normvec_phase(KP a_in_) {
    PHASE_IDS();
    float* CG = (float*)(a->ws + WS_NV); float* GV = CG + (size_t)NLAYER * 3 * 5 * DM; float* SH = GV + (size_t)NV_T * 5 * DM;
    const int gt = gw * 64 + lane, NGT = NGW * 64;
    for (int e = gt; e < NLAYER * 3 * 5 * DM; e += NGT) { const int c = e % DM, s = (e / DM) % 5, ls = e / (5 * DM), l = ls / 3, site = ls % 3;
        const float coef = site == 1 ? 1.0f : 0.5f; const int jg = site == 0 ? 2 : (site == 1 ? 5 : 8), nwp = site == 0 ? 1 : (site == 1 ? 3 : 5);
        CG[e] = coef * modp(a, l, s, jg)[c] * a->in[I_NORMW][(size_t)(l * 6 + nwp) * DM + c]; }
    for (int e = gt; e < NV_T * 5 * DM; e += NGT) { const int c = e % DM, s = (e / DM) % 5, t = e / (5 * DM);
        int l, nwp, jsh, jsc; if (t == 0) { l = 0; nwp = 0; jsh = 0; jsc = 1; } else { const int ls = t - 1, site = ls % 3; l = ls / 3; if (site == 0) { nwp = 2; jsh = 3; jsc = 4; } else if (site == 1) { nwp = 4; jsh = 6; jsc = 7; } else { l = l + 1; nwp = 0; jsh = 0; jsc = 1; } }
        if (l < NLAYER) { GV[e] = a->in[I_NORMW][(size_t)(l * 6 + nwp) * DM + c] * (1.0f + modp(a, l, s, jsc)[c]); SH[e] = modp(a, l, s, jsh)[c]; } else { GV[e] = 0.f; SH[e] = 0.f; } }
}
template <bool INIT, bool POST, bool PRE, bool FINAL>
__device__ __forceinline__ void norm_phase(KP a_in_, int row_lo, int row_hi, int cg_slot, int t_slot) {
    PHASE_IDS();
    float* XR = (float*)(a->ws + WS_XR); const bf16* Y = (const bf16*)(a->ws + WS_Y); bf16* H = (bf16*)(a->ws + WS_H);
    const float* CG = (const float*)(a->ws + WS_NV); const float* GV = CG + (size_t)NLAYER * 3 * 5 * DM; const float* SH = GV + (size_t)NV_T * 5 * DM;
    for (int row = row_lo + gw; row < row_hi; row += NGW) {
        const int s = mod_idx(row);
        f32x4 x[8], cg[8], gv[8], sh[8]; u32x2 yw[8];
        const float* xin = INIT ? (row < M_LAT ? a->in[I_X] + (size_t)row * DM : a->in[I_CTX] + (size_t)(row - M_LAT) * DM) : XR + (size_t)row * DM;
#pragma unroll
        for (int i = 0; i < 8; ++i) x[i] = __builtin_nontemporal_load((const f32x4*)(xin + (i * 64 + lane) * 4));
        f32x4 y[8];
        if (POST) {
            if (row < M_LAT) {
#pragma unroll
                for (int i = 0; i < 8; ++i) yw[i] = __builtin_nontemporal_load((const u32x2*)(Y + (size_t)row * DM + (i * 64 + lane) * 4));
            }
            const float* cgp = CG + ((size_t)cg_slot * 5 + s) * DM;
#pragma unroll
            for (int i = 0; i < 8; ++i) cg[i] = *(const f32x4*)(cgp + (i * 64 + lane) * 4);
        }
        if (PRE) { const float* gvp = GV + ((size_t)t_slot * 5 + s) * DM; const float* shp = SH + ((size_t)t_slot * 5 + s) * DM;
#pragma unroll
            for (int i = 0; i < 8; ++i) { gv[i] = *(const f32x4*)(gvp + (i * 64 + lane) * 4); sh[i] = *(const f32x4*)(shp + (i * 64 + lane) * 4); } }
        if (POST) {
            float ss = 0.f;
            if (row < M_LAT) {
#pragma unroll
                for (int i = 0; i < 8; ++i) y[i] = (f32x4){bflo(yw[i].x), bfhi(yw[i].x), bflo(yw[i].y), bfhi(yw[i].y)};
            } else {
                u32x2 pw[8][4];
#pragma unroll
                for (int i = 0; i < 8; ++i) { const bf16* yp = (const bf16*)(a->ws + WS_YP) + (size_t)(row - M_LAT) * DM + (i * 64 + lane) * 4;
#pragma unroll
                    for (int q = 0; q < 4; ++q) pw[i][q] = *(const u32x2*)(yp + (size_t)q * M_CTX * DM); }
                __builtin_amdgcn_sched_barrier(0);
#pragma unroll
                for (int i = 0; i < 8; ++i) { y[i] = (f32x4){0.f, 0.f, 0.f, 0.f};
#pragma unroll
                    for (int q = 0; q < 4; ++q) { const u32x2 w = pw[i][q]; y[i] += (f32x4){bflo(w.x), bfhi(w.x), bflo(w.y), bfhi(w.y)}; } }
            }
#pragma unroll
            for (int i = 0; i < 8; ++i) ss += y[i][0] * y[i][0] + y[i][1] * y[i][1] + y[i][2] * y[i][2] + y[i][3] * y[i][3];
            const float rs = 1.0f / sqrtf(wave_sum(ss) * (1.0f / DM) + NORM_EPS);
#pragma unroll
            for (int i = 0; i < 8; ++i) x[i] += cg[i] * (y[i] * rs);
        }
        if (FINAL) {
#pragma unroll
            for (int i = 0; i < 8; ++i) __builtin_nontemporal_store(x[i], (f32x4*)(a->out + (size_t)row * DM + (i * 64 + lane) * 4));
        } else if (POST || INIT) {
#pragma unroll
            for (int i = 0; i < 8; ++i) __builtin_nontemporal_store(x[i], (f32x4*)(XR + (size_t)row * DM + (i * 64 + lane) * 4));
        }
        if (PRE) {
            float ss = 0.f;
#pragma unroll
            for (int i = 0; i < 8; ++i) ss += x[i][0] * x[i][0] + x[i][1] * x[i][1] + x[i][2] * x[i][2] + x[i][3] * x[i][3];
            const float rs = 1.0f / sqrtf(wave_sum(ss) * (1.0f / DM) + NORM_EPS);
#pragma unroll
            for (int i = 0; i < 8; ++i) { const f32x4 h = x[i] * rs * gv[i] + sh[i]; u32x2 w; w.x = cvt_pk_bf16(h[0], h[1]); w.y = cvt_pk_bf16(h[2], h[3]); *(u32x2*)(H + (size_t)row * DM + (i * 64 + lane) * 4) = w; }
        }
    }
}

namespace pg8 {
struct EpiQ {
    static constexpr bool PERM = true, AFTER_DRAIN = false, CHAIN = false;
    unsigned char* ws_;
    __device__ __forceinline__ void operator()(const f32x4 (&acc)[2][2][4][2], const Unit& u_, int wr, int wc, int fr, int fq) const {
        Unit u = u_; asm volatile("" : "+s"(u.pm), "+s"(u.pn), "+s"(u.z), "+v"(fr), "+v"(fq));
        unsigned char* ws = ws_; asm volatile("" : "+s"(ws));
        bf16_t* QB = (bf16_t*)(ws + WS_QB); bf16_t* QC = (bf16_t*)(ws + WS_QC); const float* rope = (const float*)(ws + WS_ROPE);
        const int row0 = u.pm * BM + wr * 64 + fr; const bool lat = u.pm < (M_LAT / BM);
#pragma unroll
        for (int bj = 0; bj < 2; ++bj) { const int col = u.pn * BM + bj * HALF + wc * 32 + 8 * fq; const int head = col / 192, within = col - head * 192; const bool rp = within >= 128; const int p0 = (within - 128) >> 1;
#pragma unroll
            for (int ai = 0; ai < 2; ++ai)
#pragma unroll
                for (int m = 0; m < 4; ++m) { const int row = row0 + ai * HALF + m * 16; const f32x4 v0 = acc[ai][bj][m][0], v1 = acc[ai][bj][m][1];
                    float f[8] = {v0[0], v0[1], v0[2], v0[3], v1[0], v1[1], v1[2], v1[3]};
                    bf16_t* dst;
                    if (lat) { const int b = row >> 12, t = row & (TL - 1);
                        if (rp) { const f32x4 co = *(const f32x4*)(rope + (size_t)t * 64 + p0), sn = *(const f32x4*)(rope + (size_t)t * 64 + 32 + p0);
#pragma unroll
                            for (int q = 0; q < 4; ++q) { const float x1 = f[2 * q], x2 = f[2 * q + 1]; f[2 * q] = x1 * co[q] - x2 * sn[q]; f[2 * q + 1] = x1 * sn[q] + x2 * co[q]; } }
                        dst = QB + ((size_t)(b * 4 + head) * TL + t) * 192 + within; }
                    else { const int rr = row - M_LAT, b = rr >> 8, t = rr & (TCX - 1); dst = QC + ((size_t)(b * 4 + head) * TCX + t) * 192 + within; }
                    u32x4 w; w.x = cvt_pk_bf16(f[0], f[1]); w.y = cvt_pk_bf16(f[2], f[3]); w.z = cvt_pk_bf16(f[4], f[5]); w.w = cvt_pk_bf16(f[6], f[7]); *(u32x4*)dst = w; } }
    }
};
struct EpiKV {
    static constexpr bool PERM = true, AFTER_DRAIN = false, CHAIN = false;
    unsigned char* ws_;
    __device__ __forceinline__ void operator()(const f32x4 (&acc)[2][2][4][2], const Unit& u_, int wr, int wc, int fr, int fq) const {
        Unit u = u_; asm volatile("" : "+s"(u.pm), "+s"(u.pn), "+s"(u.z), "+v"(fr), "+v"(fq));
        unsigned char* ws = ws_; asm volatile("" : "+s"(ws));
        bf16_t* KB = (bf16_t*)(ws + WS_KB); bf16_t* VB = (bf16_t*)(ws + WS_VB);
        const int row0 = u.pm * BM + wr * 64 + fr; const bool lat = u.pm < (M_LAT / BM);
#pragma unroll
        for (int bj = 0; bj < 2; ++bj) { const int col = u.pn * BM + bj * HALF + wc * 32 + 8 * fq; const int head = col >> 8, within = col & 255;
#pragma unroll
            for (int ai = 0; ai < 2; ++ai)
#pragma unroll
                for (int m = 0; m < 4; ++m) { const int row = row0 + ai * HALF + m * 16; const f32x4 v0 = acc[ai][bj][m][0], v1 = acc[ai][bj][m][1];
                    int b, key; if (lat) { b = row >> 12; key = row & (TL - 1); } else { const int rr = row - M_LAT; b = rr >> 8; key = TL + (rr & (TCX - 1)); }
                    bf16_t* dst = within < 128 ? KB + ((size_t)(b * 4 + head) * NKEY + key) * 192 + within : VB + ((size_t)(b * 4 + head) * NKEY + key) * 128 + (within - 128);
                    u32x4 w; w.x = cvt_pk_bf16(v0[0], v0[1]); w.y = cvt_pk_bf16(v0[2], v0[3]); w.z = cvt_pk_bf16(v1[0], v1[1]); w.w = cvt_pk_bf16(v1[2], v1[3]); *(u32x4*)dst = w; } }
    }
};
struct EpiLoraW {
    static constexpr bool PERM = true, AFTER_DRAIN = false, CHAIN = false;
    KP a_; int l_; unsigned char* ws_;
    __device__ __forceinline__ void operator()(const f32x4 (&acc)[2][2][4][2], const Unit& u_, int wr, int wc, int fr, int fq) const {
        Unit u = u_; asm volatile("" : "+s"(u.pm), "+s"(u.pn), "+s"(u.z), "+v"(fr), "+v"(fq));
        unsigned char* ws = ws_; KP a = a_; int l = l_; asm volatile("" : "+s"(ws), "+s"(a), "+s"(l));
        const float* w0 = a->in[I_W0] + (size_t)l * 1024; float* W = (float*)(ws + WS_RWW);
        const int row0 = u.pm * BM + wr * 64 + fr; const int d = u.pn >> 1;
#pragma unroll
        for (int bj = 0; bj < 2; ++bj) { const int c = (u.pn & 1) * 256 + bj * HALF + wc * 32 + 8 * fq;
            const f32x4 b0 = *(const f32x4*)(w0 + d * 512 + c), b1 = *(const f32x4*)(w0 + d * 512 + c + 4);
#pragma unroll
            for (int ai = 0; ai < 2; ++ai)
#pragma unroll
                for (int m = 0; m < 4; ++m) { const int row = row0 + ai * HALF + m * 16; const f32x4 v0 = acc[ai][bj][m][0] + b0, v1 = acc[ai][bj][m][1] + b1; f32x4 o0, o1;
#pragma unroll
                    for (int j = 0; j < 4; ++j) { o0[j] = __builtin_amdgcn_exp2f(-0.8750387749f * fast_sigmoid(v0[j])); o1[j] = __builtin_amdgcn_exp2f(-0.8750387749f * fast_sigmoid(v1[j])); }
                    float* dst = W + ((size_t)d * MT + row) * BW + c; *(f32x4*)dst = o0; *(f32x4*)(dst + 4) = o1; } }
    }
};
struct EpiLoraA {
    static constexpr bool PERM = true, AFTER_DRAIN = false, CHAIN = false;
    KP a_; int l_; unsigned char* ws_;
    __device__ __forceinline__ void operator()(const f32x4 (&acc)[2][2][4][2], const Unit& u_, int wr, int wc, int fr, int fq) const {
        Unit u = u_; asm volatile("" : "+s"(u.pm), "+s"(u.pn), "+s"(u.z), "+v"(fr), "+v"(fq));
        unsigned char* ws = ws_; KP a = a_; int l = l_; asm volatile("" : "+s"(ws), "+s"(a), "+s"(l));
        const float* a0 = a->in[I_A0] + (size_t)l * 1024; const float* ka = a->in[I_KA] + (size_t)l * 512;
        const bf16_t* Kb = (const bf16_t*)(ws + WS_RWKB); const bf16_t* KKb = (const bf16_t*)(ws + WS_RWB);
        bf16_t* KD = (bf16_t*)(ws + WS_RWB) + (size_t)3 * MT * BW; bf16_t* BB = (bf16_t*)(ws + WS_RWB) + (size_t)5 * MT * BW;
        const int row0 = u.pm * BM + wr * 64 + fr; const int d = u.pn >> 1;
#pragma unroll
        for (int bj = 0; bj < 2; ++bj) { const int c = (u.pn & 1) * 256 + bj * HALF + wc * 32 + 8 * fq;
            const f32x4 b0 = *(const f32x4*)(a0 + d * 512 + c), b1 = *(const f32x4*)(a0 + d * 512 + c + 4), ka0 = *(const f32x4*)(ka + c), ka1 = *(const f32x4*)(ka + c + 4);
#pragma unroll
            for (int ai = 0; ai < 2; ++ai)
#pragma unroll
                for (int m = 0; m < 4; ++m) { const int row = row0 + ai * HALF + m * 16; const f32x4 v0 = acc[ai][bj][m][0] + b0, v1 = acc[ai][bj][m][1] + b1;
                    const u32x4 kw = *(const u32x4*)(Kb + (size_t)row * BW + c), kkw = *(const u32x4*)(KKb + (size_t)row * BW + c);
                    const float k[8] = {bflo(kw.x), bfhi(kw.x), bflo(kw.y), bfhi(kw.y), bflo(kw.z), bfhi(kw.z), bflo(kw.w), bfhi(kw.w)};
                    const float kk[8] = {bflo(kkw.x), bfhi(kkw.x), bflo(kkw.y), bfhi(kkw.y), bflo(kkw.z), bfhi(kkw.z), bflo(kkw.w), bfhi(kkw.w)};
                    float kd[8], bb[8];
#pragma unroll
                    for (int j = 0; j < 4; ++j) { const float av0 = fast_sigmoid(v0[j]), av1 = fast_sigmoid(v1[j]); kd[j] = k[j] * (1.0f + (av0 - 1.0f) * ka0[j]); kd[4 + j] = k[4 + j] * (1.0f + (av1 - 1.0f) * ka1[j]); bb[j] = kk[j] * av0; bb[4 + j] = kk[4 + j] * av1; }
                    u32x4 w1; w1.x = cvt_pk_bf16(kd[0], kd[1]); w1.y = cvt_pk_bf16(kd[2], kd[3]); w1.z = cvt_pk_bf16(kd[4], kd[5]); w1.w = cvt_pk_bf16(kd[6], kd[7]); *(u32x4*)(KD + ((size_t)d * MT + row) * BW + c) = w1;
                    u32x4 w2; w2.x = cvt_pk_bf16(bb[0], bb[1]); w2.y = cvt_pk_bf16(bb[2], bb[3]); w2.z = cvt_pk_bf16(bb[4], bb[5]); w2.w = cvt_pk_bf16(bb[6], bb[7]); *(u32x4*)(BB + ((size_t)d * MT + row) * BW + c) = w2;
                    asm volatile("" ::: "memory"); } }
    }
};
__device__ __forceinline__ size_t gz_off(int pm, int k, int pn, int g, int wave, int lane) { return ((((size_t)((pm * 4 + k) * 8 + pn) * 16 + g) * 8 + wave) * 64 + lane) * 8; }
struct EpiZ {
    static constexpr bool PERM = true, AFTER_DRAIN = false, CHAIN = false;
    bf16_t* O; bf16_t* GZ; const float* gate_b;
    __device__ __forceinline__ void operator()(const f32x4 (&acc)[2][2][4][2], const Unit& u_, int wr, int wc, int fr, int fq) const {
        Unit u = u_; asm volatile("" : "+s"(u.pm), "+s"(u.pn), "+s"(u.z), "+v"(fr), "+v"(fq));
        if (u.pn < Z_G / BM) {
            const int row0 = u.pm * BM + wr * 64 + fr; const int col0 = u.pn * BM + wc * 32 + 8 * fq;
#pragma unroll
            for (int bj = 0; bj < 2; ++bj)
#pragma unroll
                for (int ai = 0; ai < 2; ++ai)
#pragma unroll
                    for (int m = 0; m < 4; ++m) { const f32x4 v0 = acc[ai][bj][m][0], v1 = acc[ai][bj][m][1];
                        u32x4 w; w.x = cvt_pk_bf16(v0[0], v0[1]); w.y = cvt_pk_bf16(v0[2], v0[3]); w.z = cvt_pk_bf16(v1[0], v1[1]); w.w = cvt_pk_bf16(v1[2], v1[3]);
                        *(u32x4*)(O + (size_t)(row0 + ai * HALF + m * 16) * ZP + col0 + bj * HALF) = w; }
        } else {
            const int t = u.pn - Z_G / BM, k = t >> 3, pn = t & 7, wave = wr * 4 + wc, lane = fq * 16 + fr;
#pragma unroll
            for (int bj = 0; bj < 2; ++bj) { const int c = k * 2048 + pn * BM + bj * HALF + wc * 32 + 8 * fq;
                const f32x4 b0 = *(const f32x4*)(gate_b + c), b1 = *(const f32x4*)(gate_b + c + 4);
#pragma unroll
                for (int ai = 0; ai < 2; ++ai)
#pragma unroll
                    for (int m = 0; m < 4; ++m) { f32x4 v0 = acc[ai][bj][m][0], v1 = acc[ai][bj][m][1];
#pragma unroll
                        for (int j = 0; j < 4; ++j) { v0[j] = fast_sigmoid(fmaxf(v0[j] + b0[j], -60.f)); v1[j] = fast_sigmoid(fmaxf(v1[j] + b1[j], -60.f)); }
                        u32x4 w; w.x = cvt_pk_bf16(v0[0], v0[1]); w.y = cvt_pk_bf16(v0[2], v0[3]); w.z = cvt_pk_bf16(v1[0], v1[1]); w.w = cvt_pk_bf16(v1[2], v1[3]);
                        __builtin_nontemporal_store(w, (u32x4*)(GZ + gz_off(u.pm, k, pn, (bj * 2 + ai) * 4 + m, wave, lane))); } }
        }
    }
};
struct EpiGateH {
    static constexpr bool PERM = true, AFTER_DRAIN = false, CHAIN = true;
    const bf16_t* GZ; bf16_t* MG; int ldc;
#define GH_LD(bt, q) do { _Pragma("unroll") for (int i_ = 0; i_ < 4; ++i_) { za[q][i_] = __builtin_nontemporal_load((const u32x4*)(pa + (size_t)((bt) * 4 + i_) * 4096)); zb[q][i_] = __builtin_nontemporal_load((const u32x4*)(pb + (size_t)((bt) * 4 + i_) * 4096)); } } while (0)
#define GH_MUL(bt, q) do { _Pragma("unroll") for (int m = 0; m < 4; ++m) { const u32x4 a_ = za[q][m], b_ = zb[q][m]; \
        const float ga[8] = {bflo(a_.x), bfhi(a_.x), bflo(a_.y), bfhi(a_.y), bflo(a_.z), bfhi(a_.z), bflo(a_.w), bfhi(a_.w)}; \
        const float gb[8] = {bflo(b_.x), bfhi(b_.x), bflo(b_.y), bfhi(b_.y), bflo(b_.z), bfhi(b_.z), bflo(b_.w), bfhi(b_.w)}; \
        _Pragma("unroll") for (int j = 0; j < 8; ++j) acc[(bt) & 1][(bt) >> 1][m][j >> 2][j & 3] *= ga[j] * __builtin_amdgcn_rcpf(gb[j]); } } while (0)
    __device__ __forceinline__ void mid(f32x4 (&acc)[2][2][4][2], const Unit& u_, int seg, int wr, int wc, int fr, int fq) const {
        Unit u = u_; asm volatile("" : "+s"(u.pm), "+s"(u.pn), "+s"(seg), "+v"(fr), "+v"(fq));
        const int wave = wr * 4 + wc, lane = fq * 16 + fr; const bf16_t* pa = GZ + gz_off(u.pm, seg, u.pn, 0, wave, lane); const bf16_t* pb = GZ + gz_off(u.pm, seg + 1, u.pn, 0, wave, lane);
        u32x4 za[2][4], zb[2][4];
        GH_LD(0, 0); GH_LD(1, 1); __builtin_amdgcn_sched_barrier(0);
        GH_MUL(0, 0); __builtin_amdgcn_sched_barrier(0);
        GH_LD(2, 0); __builtin_amdgcn_sched_barrier(0);
        GH_MUL(1, 1); __builtin_amdgcn_sched_barrier(0);
        GH_LD(3, 1); __builtin_amdgcn_sched_barrier(0);
        GH_MUL(2, 0); __builtin_amdgcn_sched_barrier(0);
        GH_MUL(3, 1);
    }
#undef GH_LD
#undef GH_MUL
    __device__ __forceinline__ void operator()(const f32x4 (&acc)[2][2][4][2], const Unit& u_, int wr, int wc, int fr, int fq) const {
        Unit u = u_; asm volatile("" : "+s"(u.pm), "+s"(u.pn), "+s"(u.z), "+v"(fr), "+v"(fq));
        const int row0 = u.pm * BM + wr * 64 + fr; const int col0 = u.pn * BM + wc * 32 + 8 * fq; const int wave = wr * 4 + wc, lane = fq * 16 + fr;
        const bf16_t* pg = GZ + gz_off(u.pm, 3, u.pn, 0, wave, lane);
        u32x4 zq[16];
#pragma unroll
        for (int g = 0; g < 16; ++g) zq[g] = __builtin_nontemporal_load((const u32x4*)(pg + (size_t)g * 4096));
        __builtin_amdgcn_sched_barrier(0);
#pragma unroll
        for (int bj = 0; bj < 2; ++bj) { const int col = col0 + bj * HALF;
#pragma unroll
            for (int ai = 0; ai < 2; ++ai)
#pragma unroll
                for (int m = 0; m < 4; ++m) { const int row = row0 + ai * HALF + m * 16;
                    const u32x4 zg = zq[(bj * 2 + ai) * 4 + m];
                    const f32x4 v0 = acc[ai][bj][m][0] * (f32x4){bflo(zg.x), bfhi(zg.x), bflo(zg.y), bfhi(zg.y)}, v1 = acc[ai][bj][m][1] * (f32x4){bflo(zg.z), bfhi(zg.z), bflo(zg.w), bfhi(zg.w)};
                    u32x4 w; w.x = cvt_pk_bf16(v0[0], v0[1]); w.y = cvt_pk_bf16(v0[2], v0[3]); w.z = cvt_pk_bf16(v1[0], v1[1]); w.w = cvt_pk_bf16(v1[2], v1[3]);
                    *(u32x4*)(MG + (size_t)row * ldc + col) = w; } }
    }
};
struct EpiLru {
    static constexpr bool PERM = true, AFTER_DRAIN = false, CHAIN = false;
    KP a_; int l_; unsigned char* ws_;
    __device__ __forceinline__ void operator()(const f32x4 (&acc)[2][2][4][2], const Unit& u_, int wr, int wc, int fr, int fq) const {
        Unit u = u_; asm volatile("" : "+s"(u.pm), "+s"(u.pn), "+s"(u.z), "+v"(fr), "+v"(fq));
        unsigned char* ws = ws_; KP a = a_; int l = l_; asm volatile("" : "+s"(ws), "+s"(a), "+s"(l));
        const float* ba = a->in[I_BA] + (size_t)l * 1024; const float* bx = a->in[I_BX] + (size_t)l * 1024; const float* lam = (const float*)(ws + WS_LRUSP) + (size_t)l * 1024;
        const bf16_t* XCVB = (const bf16_t*)(ws + WS_XCVB); float* LRA = (float*)(ws + WS_LRA); float* LRB = (float*)(ws + WS_LRB);
        const int row0 = u.pm * BM + wr * 64 + fr; const int d = u.pn >> 2, c = (u.pn & 3) * 128 + wc * 32 + 8 * fq;
        float sp[8], cba[8], cbx[8];
#pragma unroll
        for (int j = 0; j < 8; ++j) { sp[j] = lam[d * 512 + c + j]; cba[j] = ba[d * 512 + c + j]; cbx[j] = bx[d * 512 + c + j]; }
#pragma unroll
        for (int ai = 0; ai < 2; ++ai)
#pragma unroll
            for (int m = 0; m < 4; ++m) { const int row = row0 + ai * HALF + m * 16; const u32x4 xw = *(const u32x4*)(XCVB + (size_t)row * BW + c);
                const float xc[8] = {bflo(xw.x), bfhi(xw.x), bflo(xw.y), bfhi(xw.y), bflo(xw.z), bfhi(xw.z), bflo(xw.w), bfhi(xw.w)};
                float av[8], bv[8];
#pragma unroll
                for (int j = 0; j < 8; ++j) { const float g_r = fast_sigmoid(acc[ai][0][m][j >> 2][j & 3] + cba[j]), g_i = fast_sigmoid(acc[ai][1][m][j >> 2][j & 3] + cbx[j]);
                    const float a_ = __builtin_amdgcn_exp2f(g_r * sp[j]); av[j] = a_; bv[j] = __builtin_amdgcn_sqrtf(fmaxf(1.0f - a_ * a_, 0.f)) * g_i * xc[j]; }
                float* da = LRA + ((size_t)d * MT + row) * BW + c; float* db = LRB + ((size_t)d * MT + row) * BW + c;
                *(f32x4*)da = (f32x4){av[0], av[1], av[2], av[3]}; *(f32x4*)(da + 4) = (f32x4){av[4], av[5], av[6], av[7]};
                *(f32x4*)db = (f32x4){bv[0], bv[1], bv[2], bv[3]}; *(f32x4*)(db + 4) = (f32x4){bv[4], bv[5], bv[6], bv[7]}; }
    }
};
}

namespace rwc {
__device__ __forceinline__ bf16x8 frag4(unsigned a, unsigned b, unsigned c, unsigned d) { u32x4 w = {a, b, c, d}; return *reinterpret_cast<bf16x8*>(&w); }
__device__ __forceinline__ bf16x8 pack_lo(const f32x4& c) { return frag4(cvt_pk_bf16(c[0], c[1]), cvt_pk_bf16(c[2], c[3]), 0u, 0u); }
__device__ __forceinline__ bf16x8 pack2(const f32x4& lo, const f32x4& hi) { return frag4(cvt_pk_bf16(lo[0], lo[1]), cvt_pk_bf16(lo[2], lo[3]), cvt_pk_bf16(hi[0], hi[1]), cvt_pk_bf16(hi[2], hi[3])); }
__device__ __forceinline__ f32x4 mma(bf16x8 a, bf16x8 b, f32x4 c) { return __builtin_amdgcn_mfma_f32_16x16x32_bf16(a, b, c, 0, 0, 0); }
constexpr int RAW_W = 0, RAW_KK = 4096, RAW_BB = 6144, RAW_KD = 8192, RAW_R = 10240, RAW_V = 12288;
constexpr int TS = 144;
constexpr int A_T = 0, R_T = 16 * TS, B_T = 32 * TS, K_T = 48 * TS, B_TR = 64 * TS, K_TR = B_TR + 64 * 48, CL_O = K_TR + 64 * 48;
}
constexpr int PREP_ITEM = 1024, PREP_BYTES = 10 * PREP_ITEM + 256;
constexpr int NCHK = NSTEP / 16, NJOBS = 64 * NCHK;
__device__ __forceinline__ void rwkv_prep_wave(KP a, int first, int stride, int NJ  , LAS unsigned char* ldsw  , int lane) {
    using namespace rwc;
    const int n = lane & 15, q = lane >> 4;
    if (first >= NJ) return;
    const f32x4 zero4 = (f32x4){0.f, 0.f, 0.f, 0.f};
    const float* RWWp = (const float*)(a->ws + WS_RWW); const bf16* RWB = (const bf16*)(a->ws + WS_RWB);
    u32x4 pw[4], pkk[2], pbb[2], pkd[2], pr[2];
#define RWC_LOAD(job) do { const int chain_ = (job) / NCHK, ch_ = (job) - chain_ * NCHK, d_ = chain_ >> 5, b_ = (chain_ >> 3) & 3, h_ = chain_ & 7, s0_ = ch_ * 16; \
        _Pragma("unroll") for (int i_ = 0; i_ < 4; ++i_) pw[i_] = __builtin_nontemporal_load((const u32x4*)(RWWp + (size_t)d_ * MT * BW + h_ * 64 + (lane & 15) * 4 + (size_t)scan_row(s0_ + 4 * i_ + (lane >> 4), d_, b_) * BW)); \
        _Pragma("unroll") for (int i_ = 0; i_ < 2; ++i_) { const size_t ro_ = (size_t)scan_row(s0_ + 8 * i_ + (lane >> 3), d_, b_) * BW + h_ * 64 + (lane & 7) * 8; \
            pkk[i_] = *(const u32x4*)(RWB + ro_); pbb[i_] = *(const u32x4*)(RWB + (size_t)(5 + d_) * MT * BW + ro_); pkd[i_] = *(const u32x4*)(RWB + (size_t)(3 + d_) * MT * BW + ro_); pr[i_] = *(const u32x4*)(RWB + (size_t)1 * MT * BW + ro_); } } while (0)
#define RWC_STORE_RAW() do { \
        _Pragma("unroll") for (int i_ = 0; i_ < 4; ++i_) *(LAS u32x4*)(ldsw + RAW_W + (i_ * 64 + lane) * 16) = pw[i_]; \
        _Pragma("unroll") for (int i_ = 0; i_ < 2; ++i_) { *(LAS u32x4*)(ldsw + RAW_KK + (i_ * 64 + lane) * 16) = pkk[i_]; *(LAS u32x4*)(ldsw + RAW_BB + (i_ * 64 + lane) * 16) = pbb[i_]; \
            *(LAS u32x4*)(ldsw + RAW_KD + (i_ * 64 + lane) * 16) = pkd[i_]; *(LAS u32x4*)(ldsw + RAW_R + (i_ * 64 + lane) * 16) = pr[i_]; } } while (0)
    RWC_LOAD(first); RWC_STORE_RAW();
    LDS_WAIT(); asm volatile("" ::: "memory");
    for (int job = first; job < NJ; job += stride) {
        if (job + stride < NJ) RWC_LOAD(job + stride);
        float wv[16]; unsigned kkv[16], bbv[16], kdv[16], rv[16];
#pragma unroll
        for (int t = 0; t < 16; ++t) { wv[t] = *(LAS const float*)(ldsw + RAW_W + t * 256 + lane * 4);
            kkv[t] = *(LAS const unsigned short*)(ldsw + RAW_KK + t * 128 + lane * 2); bbv[t] = *(LAS const unsigned short*)(ldsw + RAW_BB + t * 128 + lane * 2);
            kdv[t] = *(LAS const unsigned short*)(ldsw + RAW_KD + t * 128 + lane * 2); rv[t] = *(LAS const unsigned short*)(ldsw + RAW_R + t * 128 + lane * 2); }
        LDS_WAIT(); asm volatile("" ::: "memory");
        {
            float c = 1.0f; unsigned btr[8], ktr[8];
#pragma unroll
            for (int t = 0; t < 16; t += 2) {
                float at[2], bt[2], kt[2], rt[2];
#pragma unroll
                for (int u = 0; u < 2; ++u) { const float cprev = c; c *= wv[t + u]; const float rc = __builtin_amdgcn_rcpf(c);
                    at[u] = -__uint_as_float(kkv[t + u] << 16) * cprev; bt[u] = __uint_as_float(bbv[t + u] << 16) * rc; kt[u] = __uint_as_float(kdv[t + u] << 16) * rc; rt[u] = __uint_as_float(rv[t + u] << 16) * c; }
                const unsigned pa = cvt_pk_bf16(at[0], at[1]), pb = cvt_pk_bf16(bt[0], bt[1]), pk = cvt_pk_bf16(kt[0], kt[1]), pr_ = cvt_pk_bf16(rt[0], rt[1]);
                *(LAS unsigned short*)(ldsw + A_T + t * TS + lane * 2) = (unsigned short)pa; *(LAS unsigned short*)(ldsw + A_T + (t + 1) * TS + lane * 2) = (unsigned short)(pa >> 16);
                *(LAS unsigned short*)(ldsw + R_T + t * TS + lane * 2) = (unsigned short)pr_; *(LAS unsigned short*)(ldsw + R_T + (t + 1) * TS + lane * 2) = (unsigned short)(pr_ >> 16);
                *(LAS unsigned short*)(ldsw + B_T + t * TS + lane * 2) = (unsigned short)pb; *(LAS unsigned short*)(ldsw + B_T + (t + 1) * TS + lane * 2) = (unsigned short)(pb >> 16);
                *(LAS unsigned short*)(ldsw + K_T + t * TS + lane * 2) = (unsigned short)pk; *(LAS unsigned short*)(ldsw + K_T + (t + 1) * TS + lane * 2) = (unsigned short)(pk >> 16);
                btr[t >> 1] = pb; ktr[t >> 1] = pk;
            }
            *(LAS u32x4*)(ldsw + B_TR + lane * 48) = (u32x4){btr[0], btr[1], btr[2], btr[3]}; *(LAS u32x4*)(ldsw + B_TR + lane * 48 + 16) = (u32x4){btr[4], btr[5], btr[6], btr[7]};
            *(LAS u32x4*)(ldsw + K_TR + lane * 48) = (u32x4){ktr[0], ktr[1], ktr[2], ktr[3]}; *(LAS u32x4*)(ldsw + K_TR + lane * 48 + 16) = (u32x4){ktr[4], ktr[5], ktr[6], ktr[7]};
            *(LAS float*)(ldsw + CL_O + lane * 4) = c;
        }
        LDS_WAIT(); asm volatile("" ::: "memory");
        bf16x8 FA[2], FB[2], FK[2], FR[2];
#pragma unroll
        for (int m = 0; m < 2; ++m) { const int o = n * TS + (32 * m + 4 * q) * 2;
            { const u32x2 lo = *(LAS const u32x2*)(ldsw + A_T + o), hi = *(LAS const u32x2*)(ldsw + A_T + o + 32); FA[m] = frag4(lo.x, lo.y, hi.x, hi.y); }
            { const u32x2 lo = *(LAS const u32x2*)(ldsw + B_T + o), hi = *(LAS const u32x2*)(ldsw + B_T + o + 32); FB[m] = frag4(lo.x, lo.y, hi.x, hi.y); }
            { const u32x2 lo = *(LAS const u32x2*)(ldsw + K_T + o), hi = *(LAS const u32x2*)(ldsw + K_T + o + 32); FK[m] = frag4(lo.x, lo.y, hi.x, hi.y); }
            { const u32x2 lo = *(LAS const u32x2*)(ldsw + R_T + o), hi = *(LAS const u32x2*)(ldsw + R_T + o + 32); FR[m] = frag4(lo.x, lo.y, hi.x, hi.y); } }
        f32x4 Nba = mma(FB[1], FA[1], mma(FB[0], FA[0], zero4));
        f32x4 NbaT = mma(FA[1], FB[1], mma(FA[0], FB[0], zero4));
        f32x4 Nka = mma(FK[1], FA[1], mma(FK[0], FA[0], zero4));
        f32x4 Mbr = mma(FB[1], FR[1], mma(FB[0], FR[0], zero4));
        f32x4 Mkr = mma(FK[1], FR[1], mma(FK[0], FR[0], zero4));
#pragma unroll
        for (int r = 0; r < 4; ++r) { const int s = 4 * q + r;
            Nba[r] = s < n ? Nba[r] : 0.f; Nka[r] = s < n ? Nka[r] : 0.f; NbaT[r] = n < s ? NbaT[r] : 0.f; Mbr[r] = s <= n ? Mbr[r] : 0.f; Mkr[r] = s <= n ? Mkr[r] : 0.f; }
        f32x4 Tm;
        {
            f32x4 Id;
#pragma unroll
            for (int r = 0; r < 4; ++r) Id[r] = (4 * q + r == n) ? 1.0f : 0.f;
            const bf16x8 pN = pack_lo(Nba), pNT = pack_lo(NbaT);
            const f32x4 N2 = mma(pNT, pN, zero4), N2T = mma(pN, pNT, zero4);
            const bf16x8 pN2 = pack_lo(N2), pN2T = pack_lo(N2T);
            const f32x4 N4 = mma(pN2T, pN2, zero4), N4T = mma(pN2, pN2T, zero4);
            const bf16x8 pN4 = pack_lo(N4), pN4T = pack_lo(N4T);
            const f32x4 N8 = mma(pN4T, pN4, zero4);
            const bf16x8 pF0T = pack_lo(NbaT + Id), pF1 = pack_lo(N2 + Id);
            const f32x4 T1 = mma(pF0T, pF1, zero4), T1T = mma(pF1, pF0T, zero4);
            const bf16x8 pT1T = pack_lo(T1T), pF2 = pack_lo(N4 + Id);
            const f32x4 T2T = mma(pF2, pT1T, zero4);
            (void)T1;
            const bf16x8 pT2T = pack_lo(T2T), pF3 = pack_lo(N8 + Id);
            Tm = mma(pT2T, pF3, zero4);
        }
        { unsigned char* pp = a->ws + WS_PREP + (size_t)job * PREP_BYTES + lane * 16;
          *(bf16x8*)(pp + 0 * PREP_ITEM) = FA[0]; *(bf16x8*)(pp + 1 * PREP_ITEM) = FA[1]; *(bf16x8*)(pp + 2 * PREP_ITEM) = FR[0]; *(bf16x8*)(pp + 3 * PREP_ITEM) = FR[1];
          *(u32x4*)(pp + 4 * PREP_ITEM) = (u32x4){cvt_pk_bf16(Nka[0], Nka[1]), cvt_pk_bf16(Nka[2], Nka[3]), cvt_pk_bf16(Tm[0], Tm[1]), cvt_pk_bf16(Tm[2], Tm[3])};
          *(bf16x8*)(pp + 5 * PREP_ITEM) = pack2(Mbr, Mkr);
#pragma unroll
          for (int J = 0; J < 4; ++J) { const u32x2 bl = *(LAS const u32x2*)(ldsw + B_TR + (16 * J + n) * 48 + q * 8), kl = *(LAS const u32x2*)(ldsw + K_TR + (16 * J + n) * 48 + q * 8);
              *(u32x4*)(pp + (6 + J) * PREP_ITEM) = (u32x4){bl.x, bl.y, kl.x, kl.y}; }
          ((float*)(a->ws + WS_PREP + (size_t)job * PREP_BYTES + 10 * PREP_ITEM))[lane] = *(LAS const float*)(ldsw + CL_O + lane * 4); }
        LDS_WAIT(); asm volatile("" ::: "memory");
        if (job + stride < NJ) { RWC_STORE_RAW(); LDS_WAIT(); asm volatile("" ::: "memory"); }
    }
#undef RWC_LOAD
#undef RWC_STORE_RAW
}

__device__ __forceinline__ void rwkv_scan_wave(KP a, int chain, int slab, int lane) {
    using namespace rwc;
    const int d = chain >> 5, b = (chain >> 3) & 3, h = chain & 7, n = lane & 15, q = lane >> 4;
    const f32x4 zero4 = (f32x4){0.f, 0.f, 0.f, 0.f};
    const unsigned char* pbase = a->ws + WS_PREP + (size_t)chain * NCHK * PREP_BYTES;
    const bf16* gV = (const bf16*)(a->ws + WS_RWB) + (size_t)2 * MT * BW + h * 64 + slab * 16 + n;
    bf16* gY = (bf16*)(a->ws + WS_RWY) + (size_t)d * MT * BW + h * 64 + slab * 16 + n;
    f32x4 St[4] = {zero4, zero4, zero4, zero4};
    u32x4 eA[3], eB[3], lt[7]; f32x4 cl[4]; unsigned short vvA[4], vvB[4];
#define RWS_LOAD_E(e, vv, ch_) do { const unsigned char* pp_ = pbase + (size_t)(ch_) * PREP_BYTES + lane * 16; \
        e[0] = *(const u32x4*)(pp_ + 0 * PREP_ITEM); e[1] = *(const u32x4*)(pp_ + 1 * PREP_ITEM); e[2] = *(const u32x4*)(pp_ + 4 * PREP_ITEM); \
        _Pragma("unroll") for (int e_ = 0; e_ < 4; ++e_) vv[e_] = gV[(size_t)scan_row((ch_) * 16 + 4 * q + e_, d, b) * BW]; } while (0)
#define RWS_LOAD_L(ch_) do { const unsigned char* pp_ = pbase + (size_t)(ch_) * PREP_BYTES; \
        lt[0] = *(const u32x4*)(pp_ + 2 * PREP_ITEM + lane * 16); lt[1] = *(const u32x4*)(pp_ + 3 * PREP_ITEM + lane * 16); lt[2] = *(const u32x4*)(pp_ + 5 * PREP_ITEM + lane * 16); \
        _Pragma("unroll") for (int i_ = 0; i_ < 4; ++i_) lt[3 + i_] = *(const u32x4*)(pp_ + (6 + i_) * PREP_ITEM + lane * 16); \
        _Pragma("unroll") for (int J_ = 0; J_ < 4; ++J_) cl[J_] = *(const f32x4*)(pp_ + 10 * PREP_ITEM + (16 * J_ + 4 * q) * 4); } while (0)
#define RWS_STEP(e, vv, ch_) do { \
        const bf16x8 FA0 = *reinterpret_cast<bf16x8*>(&e[0]), FA1 = *reinterpret_cast<bf16x8*>(&e[1]), FR0 = *reinterpret_cast<bf16x8*>(&lt[0]), FR1 = *reinterpret_cast<bf16x8*>(&lt[1]); \
        const bf16x8 pNka = frag4(e[2].x, e[2].y, 0u, 0u), pT = frag4(e[2].z, e[2].w, 0u, 0u), pMM = *reinterpret_cast<bf16x8*>(&lt[2]); \
        const bf16x8 BK0 = *reinterpret_cast<bf16x8*>(&lt[3]), BK1 = *reinterpret_cast<bf16x8*>(&lt[4]), BK2 = *reinterpret_cast<bf16x8*>(&lt[5]), BK3 = *reinterpret_cast<bf16x8*>(&lt[6]); \
        const f32x4 c0 = cl[0], c1 = cl[1], c2 = cl[2], c3 = cl[3]; \
        const unsigned Vlo = (unsigned)vv[0] | ((unsigned)vv[1] << 16), Vhi = (unsigned)vv[2] | ((unsigned)vv[3] << 16); \
        if ((ch_) + 2 < NCHK) RWS_LOAD_E(e, vv, (ch_) + 2); \
        if ((ch_) + 1 < NCHK) RWS_LOAD_L((ch_) + 1); \
        const bf16x8 Sb0 = pack2(St[0], St[1]), Sb1 = pack2(St[2], St[3]); \
        f32x4 XT = mma(FA1, Sb1, mma(FA0, Sb0, zero4));                                            \
        XT = mma(pNka, frag4(Vlo, Vhi, 0u, 0u), XT);                                               \
        const f32x4 UT = mma(pT, pack_lo(XT), zero4);                                              \
        const bf16x8 UVb = frag4(cvt_pk_bf16(UT[0], UT[1]), cvt_pk_bf16(UT[2], UT[3]), Vlo, Vhi);     \
        f32x4 YT = mma(FR1, Sb1, mma(FR0, Sb0, zero4)); \
        YT = mma(pMM, UVb, YT); \
        St[0] = mma(BK0, UVb, St[0]) * c0; St[1] = mma(BK1, UVb, St[1]) * c1; St[2] = mma(BK2, UVb, St[2]) * c2; St[3] = mma(BK3, UVb, St[3]) * c3; \
        _Pragma("unroll") for (int r = 0; r < 4; ++r) gY[(size_t)scan_row((ch_) * 16 + 4 * q + r, d, b) * BW] = (bf16)cvt_pk_bf16(YT[r], 0.f); } while (0)
    RWS_LOAD_E(eA, vvA, 0); RWS_LOAD_E(eB, vvB, 1); RWS_LOAD_L(0);
    for (int ch = 0; ch < NCHK; ch += 2) {
        RWS_STEP(eA, vvA, ch);
        RWS_STEP(eB, vvB, ch + 1);
    }
#undef RWS_STEP
#undef RWS_LOAD_E
#undef RWS_LOAD_L
}

__device__ __forceinline__ void thinA_phase(KP a_in_, int l) {
    PHASE_IDS();
    unsigned char* ws = a->ws; const bf16* Z = (const bf16*)(ws + WS_Z);
    bf16* RWB = (bf16*)(ws + WS_RWB);
    for (int row = gw; row < MT; row += NGW) {
        const bf16* zr = Z + (size_t)row * ZP;
        const bool lat = row < M_LAT; int b, t, Tn; if (lat) { b = row >> 12; t = row & (TL - 1); Tn = TL; } else { b = (row - M_LAT) >> 8; t = (row - M_LAT) & (TCX - 1); Tn = TCX; }
        const bool hasp = t > 0, hasn = t < Tn - 1;
        {
            float q0[8], q1[8]; ld8bf(zr + lane * 8, q0); float ss = 0.f;
#pragma unroll
            for (int i = 0; i < 8; ++i) ss += q0[i] * q0[i];
            if (lane < 32) { ld8bf(zr + 512 + lane * 8, q1);
#pragma unroll
                for (int i = 0; i < 8; ++i) ss += q1[i] * q1[i]; }
            const float rs = 1.0f / sqrtf(wave_sum(ss) * (1.0f / 768.0f) + NORM_EPS);
            const float* qn = a->in[I_QNORM] + (size_t)l * 768; float g[8];
            ld8f(qn + lane * 8, g);
#pragma unroll
            for (int i = 0; i < 8; ++i) q0[i] *= rs * g[i];
            st8bf((bf16*)(ws + WS_CQN) + (size_t)row * 768 + lane * 8, q0);
            if (lane < 32) { ld8f(qn + 512 + lane * 8, g);
#pragma unroll
                for (int i = 0; i < 8; ++i) q1[i] *= rs * g[i];
                st8bf((bf16*)(ws + WS_CQN) + (size_t)row * 768 + 512 + lane * 8, q1); }
            float kv[8]; ld8bf(zr + Z_CKV + lane * 8, kv); float s2 = 0.f;
#pragma unroll
            for (int i = 0; i < 8; ++i) s2 += kv[i] * kv[i];
            const float rs2 = 1.0f / sqrtf(wave_sum(s2) * (1.0f / 512.0f) + NORM_EPS);
            ld8f(a->in[I_KVNORM] + (size_t)l * 512 + lane * 8, g);
#pragma unroll
            for (int i = 0; i < 8; ++i) kv[i] *= rs2 * g[i];
            st8bf((bf16*)(ws + WS_CKVN) + (size_t)row * 512 + lane * 8, kv);
        }
        if (lane < 8) { float f[8]; ld8bf(zr + Z_KR + lane * 8, f); const int key = lat ? t : TL + t;
            if (lat) { const float* rp = (const float*)(ws + WS_ROPE) + (size_t)t * 64 + lane * 4; const f32x4 co = *(const f32x4*)rp, sn = *(const f32x4*)(rp + 32);
#pragma unroll
                for (int q = 0; q < 4; ++q) { const float x1 = f[2 * q], x2 = f[2 * q + 1]; f[2 * q] = x1 * co[q] - x2 * sn[q]; f[2 * q + 1] = x1 * sn[q] + x2 * co[q]; } }
#pragma unroll
            for (int hh = 0; hh < 4; ++hh) st8bf((bf16*)(ws + WS_KB) + ((size_t)(b * 4 + hh) * NKEY + key) * 192 + 128 + lane * 8, f); }
        {
            const float* mu = a->in[I_MU] + (size_t)l * 2 * 1792;
#pragma unroll
            for (int i = 0; i < 4; ++i) {
                const int c = i * 512 + lane * 8;
                if (i < 3 || lane < 32) {
                    float z[8], zp[8], zn[8], mp[8], mn[8];
                    ld8bf(zr + Z_RW + c, z);
                    if (hasp) ld8bf(zr - ZP + Z_RW + c, zp); else {
#pragma unroll
                        for (int q = 0; q < 8; ++q) zp[q] = 0.f; }
                    if (hasn) ld8bf(zr + ZP + Z_RW + c, zn); else {
#pragma unroll
                        for (int q = 0; q < 8; ++q) zn[q] = 0.f; }
                    ld8f(mu + c, mp); ld8f(mu + 1792 + c, mn);
#pragma unroll
                    for (int q = 0; q < 8; ++q) z[q] = z[q] + (zp[q] - z[q]) * mp[q] + (zn[q] - z[q]) * mn[q];
                    if (i == 0) st8bf(RWB + 1 * (size_t)MT * BW + (size_t)row * BW + lane * 8, z);
                    else if (i == 1) { st8bf((bf16*)(ws + WS_RWKB) + (size_t)row * BW + lane * 8, z);
                        float kk[8], g[8]; ld8f(a->in[I_KK] + (size_t)l * 512 + lane * 8, g); float ss = 0.f;
#pragma unroll
                        for (int q = 0; q < 8; ++q) { kk[q] = z[q] * g[q]; ss += kk[q] * kk[q]; }
                        const float rn = 1.0f / sqrtf(sum8(ss) + 1e-12f);
#pragma unroll
                        for (int q = 0; q < 8; ++q) kk[q] *= rn;
                        st8bf(RWB + (size_t)row * BW + lane * 8, kk); }
                    else if (i == 2) st8bf(RWB + 2 * (size_t)MT * BW + (size_t)row * BW + lane * 8, z);
                    else {
#pragma unroll
                        for (int q = 0; q < 8; ++q) z[q] = lane < 8 ? (1.0f - 2.0f * fast_sigmoid(-2.0f * z[q])) : (lane < 16 ? z[q] : fast_sigmoid(z[q]));
                        st8bf((bf16*)(ws + WS_LIN) + (size_t)row * 256 + lane * 8, z); }
                }
            }
        }
        {
            const int c = lane * 8; float acc[8], w[8], x[8];
            ld8f(a->in[I_CONVB] + (size_t)l * 512 + c, acc);
            const float* cw = a->in[I_CONVW] + (size_t)l * 4 * 512 + c;
#pragma unroll
            for (int j = 0; j < 4; ++j) { const int tt = t + j - 2;
                if (tt >= 0 && tt < Tn) { ld8bf(zr + (ptrdiff_t)(j - 2) * ZP + Z_LX + c, x); ld8f(cw + j * 512, w);
#pragma unroll
                    for (int q = 0; q < 8; ++q) acc[q] += x[q] * w[q]; } }
            st8bf((bf16*)(ws + WS_XCVB) + (size_t)row * BW + c, acc);
        }
    }
}

__device__ __forceinline__ void bf8f(const u32x4 v, float (&f)[8]) { f[0] = bflo(v.x); f[1] = bfhi(v.x); f[2] = bflo(v.y); f[3] = bfhi(v.y); f[4] = bflo(v.z); f[5] = bfhi(v.z); f[6] = bflo(v.w); f[7] = bfhi(v.w); }
template <bool S5P, bool BP>
__device__ __forceinline__ void thinC_rows(KP a_in_, int l, int row0, int row_end, int step) {
    PHASE_IDS();
    unsigned char* ws = a->ws; const bf16* Z = (const bf16*)(ws + WS_Z); const bf16* RWB = (const bf16*)(ws + WS_RWB);
    bf16* YS = (bf16*)(ws + WS_YS);
    const int c = lane * 8;
    float rk[8], lw[8], lb[8], dd[8];
    if (BP) { ld8f(a->in[I_RK] + (size_t)l * 512 + c, rk); ld8f(a->in[I_LNW] + (size_t)l * 512 + c, lw); ld8f(a->in[I_LNB] + (size_t)l * 512 + c, lb); }
    if (S5P) ld8f(a->in[I_S5D] + (size_t)l * 512 + c, dd);
#define TC_NT(p_) __builtin_nontemporal_load((const u32x4*)(p_))
#define TC_LOAD(R, row_) do { const size_t ro_ = (size_t)(row_) * BW + c; \
        if (BP) { R[0] = TC_NT((const bf16*)(ws + WS_RWY) + ro_); R[1] = TC_NT((const bf16*)(ws + WS_RWY) + (size_t)MT * BW + ro_); \
            R[2] = TC_NT(RWB + (size_t)1 * MT * BW + ro_); R[3] = TC_NT(RWB + (size_t)2 * MT * BW + ro_); R[4] = TC_NT(RWB + (size_t)3 * MT * BW + ro_); R[5] = TC_NT(RWB + (size_t)4 * MT * BW + ro_); \
            R[6] = TC_NT((const bf16*)(ws + WS_G) + ro_); \
            R[10] = TC_NT((const bf16*)(ws + WS_LRH) + ro_); R[11] = TC_NT((const bf16*)(ws + WS_LRH) + (size_t)MT * BW + ro_); R[12] = TC_NT(Z + (size_t)(row_) * ZP + Z_LG + c); } \
        if (S5P) { R[7] = TC_NT(Z + (size_t)(row_) * ZP + Z_S5 + c); R[8] = TC_NT((const bf16*)(ws + WS_S5Y) + ro_); R[9] = TC_NT((const bf16*)(ws + WS_S5Y) + (size_t)MT * BW + ro_); } } while (0)
    int row = row0 + wave; u32x4 cur[13];
    { unsigned z_ = 0u; asm volatile("" : "+v"(z_));
#pragma unroll
      for (int i = 0; i < 13; ++i) cur[i] = (u32x4){z_, z_, z_, z_}; }
    if (row < row_end) TC_LOAD(cur, row);
    for (; row < row_end; row += step) {
        u32x4 nxt[13];
#pragma unroll
        for (int i = 0; i < 13; ++i) nxt[i] = cur[i];
        if (row + step < row_end) TC_LOAD(nxt, row + step);
        __builtin_amdgcn_sched_barrier(0);
        const size_t ro = (size_t)row * BW + c;
        if (BP) { float y0[8], y1[8], r[8], v[8], kd0[8], kd1[8], g[8], o[8];
          bf8f(cur[0], y0); bf8f(cur[1], y1); bf8f(cur[2], r); bf8f(cur[3], v); bf8f(cur[4], kd0); bf8f(cur[5], kd1); bf8f(cur[6], g);
          float s = 0.f, bsum = 0.f;
#pragma unroll
          for (int q = 0; q < 8; ++q) { y0[q] += y1[q]; s += y0[q]; bsum += r[q] * (kd0[q] + kd1[q]) * rk[q]; }
          const float mean = sum8(s) * (1.0f / 64.0f); bsum = sum8(bsum); float vs = 0.f;
#pragma unroll
          for (int q = 0; q < 8; ++q) { const float dlt = y0[q] - mean; vs += dlt * dlt; }
          const float rstd = 1.0f / sqrtf(sum8(vs) * (1.0f / 64.0f) + 64e-5f);
#pragma unroll
          for (int q = 0; q < 8; ++q) o[q] = ((y0[q] - mean) * rstd * lw[q] + lb[q] + bsum * v[q]) * g[q];
          st8bf(YS + (size_t)1 * MT * BW + ro, o); }
        if (S5P) { float u[8], y0[8], y1[8], o[8]; bf8f(cur[7], u); bf8f(cur[8], y0); bf8f(cur[9], y1);
#pragma unroll
          for (int q = 0; q < 8; ++q) o[q] = gelu_tanh(u[q] * dd[q] + y0[q] + y1[q]);
          st8bf((bf16*)(ws + WS_TG) + ro, o); }
        if (BP) { float h0[8], h1[8], g[8], o[8]; bf8f(cur[10], h0); bf8f(cur[11], h1); bf8f(cur[12], g);
#pragma unroll
          for (int q = 0; q < 8; ++q) o[q] = (h0[q] + h1[q]) * gelu_tanh(g[q]);
          st8bf(YS + (size_t)3 * MT * BW + ro, o); }
        __builtin_amdgcn_sched_barrier(0);
#pragma unroll
        for (int i = 0; i < 13; ++i) cur[i] = nxt[i];
    }
#undef TC_LOAD
#undef TC_NT
}

__device__ __forceinline__ float dpp_sum16(float v) {
    v += __builtin_bit_cast(float, __builtin_amdgcn_update_dpp(0, __builtin_bit_cast(int, v), 0xB1, 0xF, 0xF, true));
    v += __builtin_bit_cast(float, __builtin_amdgcn_update_dpp(0, __builtin_bit_cast(int, v), 0x4E, 0xF, 0xF, true));
    v += __builtin_bit_cast(float, __builtin_amdgcn_update_dpp(0, __builtin_bit_cast(int, v), 0x141, 0xF, 0xF, true));
    v += __builtin_bit_cast(float, __builtin_amdgcn_update_dpp(0, __builtin_bit_cast(int, v), 0x140, 0xF, 0xF, true));
    return v;
}
__device__ __forceinline__ void rwkv_chain(KP a_in_, int unit, LAS unsigned char* ldsb) {
    PHASE_IDS();
    const int chain = unit >> 1, hf = unit & 1;
    const int ir = lane >> 4, cg = lane & 15;
    const int d = chain >> 5, b = (chain >> 3) & 3, h = chain & 7;
    const int myrow = hf * 32 + wave * 4 + ir;
    bf16* Yg = (bf16*)(a->ws + WS_RWY) + (size_t)d * MT * BW + h * 64 + hf * 32;
    LAS float* buf = (LAS float*)ldsb;
    LAS float* ybuf = (LAS float*)(ldsb + 2 * 16 * 6 * 64 * 4);
    const float* srcw = (const float*)(a->ws + WS_RWW) + (size_t)d * MT * BW + h * 64 + (tid & 15) * 4; const int wstep = (tid >> 4) & 15; const int wdst = (wstep * 6 + 2) * 64 + (tid & 15) * 4;
    const bf16* RWB = (const bf16*)(a->ws + WS_RWB);
    int bstep[2], bdst[2]; const bf16* bsrc[2];
#pragma unroll
    for (int q = 0; q < 2; ++q) { const int id = tid + 512 * q, v = id >> 7, st = (id >> 3) & 15, c8 = id & 7;
        const int arr = v == 0 ? 0 : (v == 1 ? 5 + d : (v == 2 ? 3 + d : (v == 3 ? 1 : 2))); const int slot = v == 0 ? 0 : (v == 1 ? 1 : (v == 2 ? 3 : (v == 3 ? 4 : 5)));
        bstep[q] = st; bdst[q] = (st * 6 + slot) * 64 + c8 * 8; bsrc[q] = RWB + (size_t)arr * MT * BW + h * 64 + c8 * 8; }
    const bool second = tid < 128;
    const int ystep = tid >> 5, yrow = tid & 31;
    f32x2 S01 = (f32x2){0.f, 0.f}, S23 = (f32x2){0.f, 0.f};
    f32x4 nw = (f32x4){0.f, 0.f, 0.f, 0.f}; u32x4 nb0 = (u32x4){0u, 0u, 0u, 0u}, nb1 = (u32x4){0u, 0u, 0u, 0u};
#define RWKV_LOAD(s0) do { if (tid < 256) nw = *(const f32x4*)(srcw + (size_t)scan_row((s0) + wstep, d, b) * BW); \
        nb0 = *(const u32x4*)(bsrc[0] + (size_t)scan_row((s0) + bstep[0], d, b) * BW); if (second) nb1 = *(const u32x4*)(bsrc[1] + (size_t)scan_row((s0) + bstep[1], d, b) * BW); } while (0)
#define RWKV_WRITE(dstbuf) do { if (tid < 256) *(LAS f32x4*)((dstbuf) + wdst) = nw; \
        *(LAS f32x4*)((dstbuf) + bdst[0]) = (f32x4){bflo(nb0.x), bfhi(nb0.x), bflo(nb0.y), bfhi(nb0.y)}; *(LAS f32x4*)((dstbuf) + bdst[0] + 4) = (f32x4){bflo(nb0.z), bfhi(nb0.z), bflo(nb0.w), bfhi(nb0.w)}; \
        if (second) { *(LAS f32x4*)((dstbuf) + bdst[1]) = (f32x4){bflo(nb1.x), bfhi(nb1.x), bflo(nb1.y), bfhi(nb1.y)}; *(LAS f32x4*)((dstbuf) + bdst[1] + 4) = (f32x4){bflo(nb1.z), bfhi(nb1.z), bflo(nb1.w), bfhi(nb1.w)}; } } while (0)
    RWKV_LOAD(0); RWKV_WRITE(buf);
    __syncthreads();
    constexpr int NCH = NSTEP / 16;
    for (int ch = 0; ch < NCH; ++ch) {
        LAS const float* cb = buf + (ch & 1) * (16 * 6 * 64);
        LAS float* yb = ybuf + (ch & 1) * (16 * 32 * 16);
        if (ch + 1 < NCH) RWKV_LOAD((ch + 1) * 16);
#pragma unroll
        for (int s = 0; s < 16; ++s) {
            LAS const float* v6 = cb + s * 6 * 64 + cg * 4;
            const f32x4 a4 = *(LAS const f32x4*)(v6), b4 = *(LAS const f32x4*)(v6 + 64), w4 = *(LAS const f32x4*)(v6 + 128), k4 = *(LAS const f32x4*)(v6 + 192), r4 = *(LAS const f32x4*)(v6 + 256);
            const float vv = cb[s * 6 * 64 + 320 + myrow];
            f32x2 t = S01 * (f32x2){a4[0], a4[1]} + S23 * (f32x2){a4[2], a4[3]};
            const float sa = -dpp_sum16(t[0] + t[1]);
            const f32x2 sav = (f32x2){sa, sa}, vvv = (f32x2){vv, vv};
            S01 = S01 * (f32x2){w4[0], w4[1]} + sav * (f32x2){b4[0], b4[1]} + vvv * (f32x2){k4[0], k4[1]};
            S23 = S23 * (f32x2){w4[2], w4[3]} + sav * (f32x2){b4[2], b4[3]} + vvv * (f32x2){k4[2], k4[3]};
            f32x2 u = S01 * (f32x2){r4[0], r4[1]} + S23 * (f32x2){r4[2], r4[3]};
            yb[(s * 32 + wave * 4 + ir) * 16 + cg] = u[0] + u[1];
        }
        if (ch + 1 < NCH) { LAS float* nbuf = buf + ((ch + 1) & 1) * (16 * 6 * 64); RWKV_WRITE(nbuf); }
        __syncthreads();
        { LAS const f32x4* yp = (LAS const f32x4*)(yb + (ystep * 32 + yrow) * 16); const f32x4 p0 = yp[0], p1 = yp[1], p2 = yp[2], p3 = yp[3];
          Yg[(size_t)scan_row(ch * 16 + ystep, d, b) * BW + yrow] = (bf16)cvt_pk_bf16(((p0[0] + p0[1]) + (p0[2] + p0[3])) + ((p1[0] + p1[1]) + (p1[2] + p1[3])) + ((p2[0] + p2[1]) + (p2[2] + p2[3])) + ((p3[0] + p3[1]) + (p3[2] + p3[3])), 0.f); }
    }
}

__device__ __forceinline__ void s5_disc(KP a, int l, int d, int g, int p, float& ar, float& ai, float& cr, float& ci) {
    const f32x4 v = *(const f32x4*)((const float*)(a->ws + WS_S5D) + ((size_t)((l * 2 + d) * 32 + g) * 64 + p) * 4); ar = v[0]; ai = v[1]; cr = v[2]; ci = v[3];
}
__device__ __forceinline__ void s5_chain(KP a, int l, int chain, LAS unsigned char* ldsw  , int lane) {
    const int d = chain >> 7, b = (chain >> 5) & 3, g = chain & 31, n16 = lane & 15, kq = lane >> 4;
    const size_t gi = (size_t)(l * 2 + d) * 32 + g;
    constexpr int DST = 132;
    float ar, ai, crp, cip; s5_disc(a, l, d, g, lane, ar, ai, crp, cip);
    bf16x8 Bf[8], Cf[4];
#pragma unroll
    for (int nb = 0; nb < 8; ++nb) { const int pp = 16 * nb + n16, p = pp & 63; float f[8];
        if (kq < 2) { float xr, xi, cr, ci; s5_disc(a, l, d, g, p, xr, xi, cr, ci); float bre[8], bim[8];
            ld8f(a->in[I_BRE] + (gi * 64 + p) * 16 + 8 * kq, bre); ld8f(a->in[I_BIM] + (gi * 64 + p) * 16 + 8 * kq, bim);
#pragma unroll
            for (int j = 0; j < 8; ++j) f[j] = pp < 64 ? (cr * bre[j] - ci * bim[j]) : (cr * bim[j] + ci * bre[j]); }
        else {
#pragma unroll
            for (int j = 0; j < 8; ++j) f[j] = 0.f; }
        u32x4 w; w.x = cvt_pk_bf16(f[0], f[1]); w.y = cvt_pk_bf16(f[2], f[3]); w.z = cvt_pk_bf16(f[4], f[5]); w.w = cvt_pk_bf16(f[6], f[7]); Bf[nb] = *reinterpret_cast<bf16x8*>(&w); }
#pragma unroll
    for (int ks = 0; ks < 4; ++ks) { const int p0 = 32 * ks + 8 * kq; float f[8];
        if (p0 < 64) ld8f(a->in[I_CRE] + (gi * 16 + n16) * 64 + p0, f); else { ld8f(a->in[I_CIM] + (gi * 16 + n16) * 64 + (p0 - 64), f);
#pragma unroll
            for (int j = 0; j < 8; ++j) f[j] = -f[j]; }
        u32x4 w; w.x = cvt_pk_bf16(f[0], f[1]); w.y = cvt_pk_bf16(f[2], f[3]); w.z = cvt_pk_bf16(f[4], f[5]); w.w = cvt_pk_bf16(f[6], f[7]); Cf[ks] = *reinterpret_cast<bf16x8*>(&w); }
    const bf16* Z = (const bf16*)(a->ws + WS_Z) + Z_S5 + g * 16 + 8 * (kq & 1);
    bf16* Yo = (bf16*)(a->ws + WS_S5Y) + (size_t)d * MT * BW + g * 16 + n16;
    constexpr int HST = 272;
    LAS float* Dsb0 = (LAS float*)ldsw; LAS float* Dsb1 = (LAS float*)(ldsw + 16 * DST * 4);
    LAS unsigned char* Hs0 = ldsw + 2 * 16 * DST * 4; LAS unsigned char* Hs1 = Hs0 + 16 * HST;
    const unsigned umask = kq < 2 ? 0xffffffffu : 0u;
    constexpr int NCH5 = NSTEP / 16;
#define S5_LOADU(c_) (*(const u32x4*)(Z + (size_t)scan_row((c_) * 16 + n16, d, b) * ZP))
#define S5_DRIVE(uw_, Dd_) do { u32x4 u_ = (uw_); u_.x &= umask; u_.y &= umask; u_.z &= umask; u_.w &= umask; const bf16x8 Uf_ = *reinterpret_cast<const bf16x8*>(&u_); \
        _Pragma("unroll") for (int nb = 0; nb < 8; ++nb) { const f32x4 D_ = __builtin_amdgcn_mfma_f32_16x16x32_bf16(Uf_, Bf[nb], (f32x4){0.f, 0.f, 0.f, 0.f}, 0, 0, 0); \
            _Pragma("unroll") for (int r = 0; r < 4; ++r) (Dd_)[(4 * kq + r) * DST + 16 * nb + n16] = D_[r]; } } while (0)
#define S5_READOUT(Hh_, c_) do { f32x4 Yv_ = (f32x4){0.f, 0.f, 0.f, 0.f}; \
        _Pragma("unroll") for (int ks = 0; ks < 4; ++ks) Yv_ = __builtin_amdgcn_mfma_f32_16x16x32_bf16(*(LAS const bf16x8*)((Hh_) + n16 * HST + (32 * ks + 8 * kq) * 2), Cf[ks], Yv_, 0, 0, 0); \
        _Pragma("unroll") for (int r = 0; r < 4; ++r) Yo[(size_t)scan_row((c_) * 16 + 4 * kq + r, d, b) * BW] = (bf16)cvt_pk_bf16(Yv_[r], 0.f); } while (0)
    float hr = 0.f, hi = 0.f;
    u32x4 unext = S5_LOADU(0);
    S5_DRIVE(unext, Dsb0);
    unext = S5_LOADU(1);
    LDS_WAIT(); asm volatile("" ::: "memory");
    for (int ch = 0; ch < NCH5; ++ch) {
        LAS float* Dc = (ch & 1) ? Dsb1 : Dsb0; LAS float* Dn = (ch & 1) ? Dsb0 : Dsb1;
        LAS unsigned char* Hc = (ch & 1) ? Hs1 : Hs0; LAS unsigned char* Hp = (ch & 1) ? Hs0 : Hs1;
        if (ch > 0) S5_READOUT(Hp, ch - 1);
        if (ch + 1 < NCH5) { S5_DRIVE(unext, Dn); if (ch + 2 < NCH5) unext = S5_LOADU(ch + 2); }
#pragma unroll
        for (int t = 0; t < 16; t += 2) {
            float h0r, h0i, h1r, h1i;
            { const float dre = Dc[t * DST + lane], dim = Dc[t * DST + 64 + lane]; h0r = ar * hr - ai * hi + dre; h0i = ar * hi + ai * hr + dim; }
            { const float dre = Dc[(t + 1) * DST + lane], dim = Dc[(t + 1) * DST + 64 + lane]; h1r = ar * h0r - ai * h0i + dre; h1i = ar * h0i + ai * h0r + dim; }
            hr = h1r; hi = h1i;
            const unsigned pr_ = cvt_pk_bf16(h0r, h1r), pi_ = cvt_pk_bf16(h0i, h1i);
            *(LAS unsigned short*)(Hc + t * HST + lane * 2) = (unsigned short)pr_; *(LAS unsigned short*)(Hc + (t + 1) * HST + lane * 2) = (unsigned short)(pr_ >> 16);
            *(LAS unsigned short*)(Hc + t * HST + 128 + lane * 2) = (unsigned short)pi_; *(LAS unsigned short*)(Hc + (t + 1) * HST + 128 + lane * 2) = (unsigned short)(pi_ >> 16);
        }
        LDS_WAIT(); asm volatile("" ::: "memory");
    }
    S5_READOUT(((NCH5 - 1) & 1) ? Hs1 : Hs0, NCH5 - 1);
#undef S5_LOADU
#undef S5_DRIVE
#undef S5_READOUT
}

__device__ __forceinline__ void lru_unit(KP a_in_, int unit, LAS unsigned char* ldsb) {
    PHASE_IDS();
    const int d = unit >> 5, b = (unit >> 3) & 3, c = (unit & 7) * 64 + lane;
    const float* A = (const float*)(a->ws + WS_LRA) + (size_t)d * MT * BW + c; const float* Bv = (const float*)(a->ws + WS_LRB) + (size_t)d * MT * BW + c; bf16* Hv = (bf16*)(a->ws + WS_LRH) + (size_t)d * MT * BW + c;
    LAS f32x2* xch = (LAS f32x2*)ldsb;
    float carry = 0.f;
    float av[32], bv[32];
#pragma unroll
    for (int i = 0; i < 32; ++i) { const size_t ro = (size_t)scan_row(wave * 32 + i, d, b) * BW; av[i] = __builtin_nontemporal_load(A + ro); bv[i] = __builtin_nontemporal_load(Bv + ro); }
    constexpr int NSB = NSTEP / 256;
    for (int sb = 0; sb < NSB; ++sb) {
        float hl[32], pl[32]; float h = 0.f, p = 1.f;
#pragma unroll
        for (int i = 0; i < 32; ++i) { h = av[i] * h + bv[i]; p = av[i] * p; hl[i] = h; pl[i] = p; }
        LAS f32x2* xb = xch + (sb & 1) * 512;
        xb[wave * 64 + lane] = (f32x2){p, h};
        if (sb + 1 < NSB) {
#pragma unroll
            for (int i = 0; i < 32; ++i) { const size_t ro = (size_t)scan_row((sb + 1) * 256 + wave * 32 + i, d, b) * BW; av[i] = __builtin_nontemporal_load(A + ro); bv[i] = __builtin_nontemporal_load(Bv + ro); } }
        __syncthreads();
        float cin = carry, c8 = carry;
#pragma unroll
        for (int u = 0; u < 8; ++u) { const f32x2 e = xb[u * 64 + lane]; c8 = e[0] * c8 + e[1]; if (u < wave) cin = c8; }
        carry = c8;
#pragma unroll
        for (int i = 0; i < 32; ++i) Hv[(size_t)scan_row(sb * 256 + wave * 32 + i, d, b) * BW] = (bf16)cvt_pk_bf16(hl[i] + pl[i] * cin, 0.f);
    }
}

constexpr int CV_STATIC_JOBS = 384;
__device__ __forceinline__ void mixer_phase(KP a_in_, int l, int qslot, unsigned char* lds_generic, LAS unsigned char* ldsb, volatile LAS unsigned* misc, bool attn_only = false) {
    PHASE_IDS(); const int blk = attn_only ? 100000 : bx_;
    if (blk < 64) {
        rwkv_prep_wave(a, blk * NCHK + wave, 8, (blk + 1) * NCHK, ldsb + wave * 16384, lane);
        asm volatile("s_waitcnt vmcnt(0)" ::: "memory");
        volatile LAS unsigned* cnt = misc + 24 + l;
        if (lane == 0) __hip_atomic_fetch_add((LAS unsigned*)cnt, 1u, __ATOMIC_RELAXED, __HIP_MEMORY_SCOPE_WORKGROUP);
        if (wave < 4) {
            for (unsigned sp = 0; *cnt < 8u && sp < (1u << 24); ++sp) __builtin_amdgcn_s_sleep(2);
            __builtin_amdgcn_fence(__ATOMIC_ACQUIRE, "agent"); asm volatile("s_waitcnt vmcnt(0)" ::: "memory");
            rwkv_scan_wave(a, blk, wave, lane);
        }
    }
    else if (blk < 128) {
        if (wave < 4) s5_chain(a, l, (blk - 64) * 4 + wave, ldsb + wave * 25600, lane);
        else if (l < NLAYER - 1 && !attn_only) { LAS float* scr = (LAS float*)(ldsb + (wave < 7 ? 102400 + (wave - 4) * 8448 : 132352));
            for (int k = 0; k < CV_STATIC_JOBS * 8 / 256; ++k) convert_wave(a, l + 1, scr, (blk - 64) * 4 + (wave - 4) + 256 * k, 8192, lane); } }
    else if (blk < 192) lru_unit(a, blk - 128, ldsb);
    __syncthreads();
    const int nunits = 256 + (l < NLAYER - 1 ? 16 : 0);
    const int njobs = (l < NLAYER - 1 && !attn_only) ? 1024 - CV_STATIC_JOBS : 0;
    unsigned* qctr = (unsigned*)(a->ws + WS_CTL) + CW_Q + 64 * qslot;
    for (;;) {
        if (tid == 0) misc[16] = __hip_atomic_fetch_add(qctr, 1u, __ATOMIC_RELAXED, __HIP_MEMORY_SCOPE_AGENT);
        __syncthreads();
        const int u = (int)misc[16];
        __syncthreads();
        if (u >= nunits + njobs) break;
        if (u >= nunits) { convert_weights(a, l + 1, ldsb, CV_STATIC_JOBS + u - nunits, 1024); __syncthreads(); continue; }
        if (u < 256) { const int bh = u >> 4, qb = u & 15, b = bh >> 2, h = bh & 3;
            att::attn_unit((const bf16*)(a->ws + WS_QB) + ((size_t)bh * TL + qb * 256) * 192, (const bf16*)(a->ws + WS_KB) + (size_t)bh * NKEY * 192, (const bf16*)(a->ws + WS_VB) + (size_t)bh * NKEY * 128,
                           (bf16*)(a->ws + WS_YS) + ((size_t)(b * TL + qb * 256)) * BW + h * 128, BW, NKEY, (char*)lds_generic);
        } else { const int bh = u - 256, b = bh >> 2, h = bh & 3;
            att::attn_unit((const bf16*)(a->ws + WS_QC) + (size_t)bh * TCX * 192, (const bf16*)(a->ws + WS_KB) + ((size_t)bh * NKEY + TL) * 192, (const bf16*)(a->ws + WS_VB) + ((size_t)bh * NKEY + TL) * 128,
                           (bf16*)(a->ws + WS_YS) + ((size_t)(M_LAT + b * TCX)) * BW + h * 128, BW, TCX, (char*)lds_generic);
        }
    }
}

struct LruOrder {
    pg8::StaticOrder S;
    __device__ __forceinline__ bool next(int i, pg8::Unit& u) const { const bool r = S.next(i, u); u.z = u.pn & 3; return r; }
    __device__ __forceinline__ void a_ready(const pg8::Unit&) const {}
    __device__ __forceinline__ void done(const pg8::Unit&) const {}
};
#ifndef PROBE_DUP_MERGE
#define PROBE_DUP_MERGE 0
#endif
#ifndef PROBE_DUP_GEMM
#define PROBE_DUP_GEMM 0
#endif
#ifndef PROBE_DUP_THIN
#define PROBE_DUP_THIN 0
#endif
#ifndef PROBE_DUP_CONV
#define PROBE_DUP_CONV 0
#endif
#ifndef PROBE_DUP_ATTN
#define PROBE_DUP_ATTN 0
#endif
#ifndef PROBE_DUP_MIXER
#define PROBE_DUP_MIXER 0
#endif
#ifndef MK_MULTI
#define MK_MULTI 0
#endif
constexpr int NPH_LAYER = 15, NPHASES = 3 + NLAYER * NPH_LAYER;
__global__ void __launch_bounds__(NWAVES * 64, 2) mega_fwd(KArgs a_by_value_unused) {
    KP a_in_ = (KP)__builtin_amdgcn_kernarg_segment_ptr(); LAUNDER_A();
    extern __shared__ __attribute__((aligned(16))) unsigned char lds[];
    LAS unsigned char* ldsb = (LAS unsigned char*)lds;
    volatile LAS unsigned* MISC = (volatile LAS unsigned*)(ldsb + MISC_OFF);
    { const int tid0 = threadIdx.x;
      for (int u = tid0; u < (LDS_BYTES - 131072) / 4; u += NWAVES * 64) ((LAS unsigned*)(ldsb + 131072))[u] = 0u;
      __syncthreads();
      if ((tid0 & 63) == 0) ((volatile LAS int*)(WAVE_TAB_OFF))[(unsigned)__builtin_amdgcn_s_getreg((5 << 11) | 4) & 63u] = tid0 >> 6;
      __syncthreads(); }
    unsigned* ctl = (unsigned*)(a->ws + WS_CTL);
    XcdBarrier bar; bar.bar = ctl + CW_BAR; bar.x = 0; bar.st = nullptr;
    if (!MK_MULTI) bar = xcd_barrier_post(ctl + CW_BAR, MISC + 8);
#if MK_MULTI
    const int lo = a->ph_lo, hi = a->ph_hi;
#define IN(k) (lo <= (k) && (k) < hi)
#define SEAM(k) do { if (IN((k) + 1)) xcd_barrier(bar); } while (0)
#else
#define IN(k) true
#define SEAM(k) xcd_barrier(bar)
#endif

    if (IN(0)) {
        tables_phase(a);
        for (int rep_ = 0; rep_ <= PROBE_DUP_CONV; ++rep_) {
        { const int nx_ = NLAYER * 72 - (int)gridDim.x;
          if (nx_ > 0 && 2 * nx_ < (int)gridDim.x) { if ((int)blockIdx.x >= nx_) convert_weights(a, 0, ldsb, (int)blockIdx.x - nx_, (int)gridDim.x - nx_); }
          else convert_weights(a, 0, ldsb, (int)blockIdx.x, (int)gridDim.x); }
        __syncthreads();
        mod_phase(a, ldsb); __syncthreads(); }
        SEAM(0);
    }
    if (IN(1)) { normvec_phase(a); SEAM(1); }
    if (IN(2)) { norm_phase<true, false, true, false>(a, 0, MT, 0, 0); SEAM(2); }

    for (int l = 0; l < NLAYER; ++l) {
        const int pb = 3 + l * NPH_LAYER;
        const bool lastl = (l == NLAYER - 1);
        const int Mpost = lastl ? M_LAT : MT;
        if (IN(pb + 0)) { LAUNDER_A(); unsigned char* ws = a->ws; unsigned char* wsw = ws + wset_off(l & 1); (void)wsw; bf16* H = (bf16*)(ws + WS_H); bf16* Y = (bf16*)(ws + WS_Y); bf16* U = (bf16*)(ws + WS_U); bf16* Zb = (bf16*)(ws + WS_Z); (void)H; (void)Y; (void)U; (void)Zb; int BX = blockIdx.x; asm volatile("" : "+s"(BX)); int G = gridDim.x; asm volatile("" : "+s"(G)); pg8::Gemm g{H, (const bf16*)(wsw + WS_W13), MT, 11264, 2048, 2048, 0, 0}; pg8::StaticOrder S; S.init(MT, 11264, G, BX);
            pg8::EpiSwiGLU E{U, DFF}; for (int rep_ = 0; rep_ <= PROBE_DUP_GEMM; ++rep_) pg8::gemm_phase<pg8::EpiSwiGLU, pg8::StaticOrder, true, true>(ldsb, g, S, E); SEAM(pb + 0); }
        if (IN(pb + 1)) { LAUNDER_A(); unsigned char* ws = a->ws; unsigned char* wsw = ws + wset_off(l & 1); (void)wsw; bf16* H = (bf16*)(ws + WS_H); bf16* Y = (bf16*)(ws + WS_Y); bf16* U = (bf16*)(ws + WS_U); bf16* Zb = (bf16*)(ws + WS_Z); (void)H; (void)Y; (void)U; (void)Zb; int BX = blockIdx.x; asm volatile("" : "+s"(BX)); int G = gridDim.x; asm volatile("" : "+s"(G));
            { pg8::Gemm g{U, (const bf16*)(wsw + WS_W2), M_LAT, 2048, DFF, DFF, 0, 0}; pg8::StaticOrder S; S.init(M_LAT, 2048, G, BX);
              pg8::EpiBf16 E{Y, DM, 0}; pg8::gemm_phase<pg8::EpiBf16, pg8::StaticOrder, true, true>(ldsb, g, S, E); }
            { pg8::Gemm g{U + (size_t)M_LAT * DFF, (const bf16*)(wsw + WS_W2), M_CTX, 2048, DFF / 4, DFF, (size_t)(DFF / 4) * 2, (size_t)(DFF / 4) * 2}; pg8::StaticOrder S; S.init(M_CTX, 2048, G, BX, 4, true);
              pg8::EpiBf16 E{(bf16*)(ws + WS_YP), DM, (size_t)M_CTX * DM}; pg8::gemm_phase<pg8::EpiBf16, pg8::StaticOrder, true, true>(ldsb, g, S, E); }
            SEAM(pb + 1); }
        if (IN(pb + 2)) { LAUNDER_A(); unsigned char* ws = a->ws; unsigned char* wsw = ws + wset_off(l & 1); (void)wsw; bf16* H = (bf16*)(ws + WS_H); bf16* Y = (bf16*)(ws + WS_Y); bf16* U = (bf16*)(ws + WS_U); bf16* Zb = (bf16*)(ws + WS_Z); (void)H; (void)Y; (void)U; (void)Zb; int BX = blockIdx.x; asm volatile("" : "+s"(BX)); int G = gridDim.x; asm volatile("" : "+s"(G)); norm_phase<false, true, true, false>(a, 0, MT, l * 3 + 0, 1 + l * 3 + 0); SEAM(pb + 2); }
        if (IN(pb + 3)) { LAUNDER_A(); unsigned char* ws = a->ws; unsigned char* wsw = ws + wset_off(l & 1); (void)wsw; bf16* H = (bf16*)(ws + WS_H); bf16* Y = (bf16*)(ws + WS_Y); bf16* U = (bf16*)(ws + WS_U); bf16* Zb = (bf16*)(ws + WS_Z); (void)H; (void)Y; (void)U; (void)Zb; int BX = blockIdx.x; asm volatile("" : "+s"(BX)); int G = gridDim.x; asm volatile("" : "+s"(G)); pg8::Gemm g{H, (const bf16*)(wsw + WS_WIN), MT, NZW, 2048, 2048, 0, 0}; pg8::StaticOrder S; S.init(MT, NZW, G, BX);
            pg8::EpiZ E{Zb, (bf16*)(ws + WS_GZ), a->in[I_GATEB] + (size_t)l * 4 * DM}; for (int rep_ = 0; rep_ <= PROBE_DUP_GEMM; ++rep_) pg8::gemm_phase<pg8::EpiZ, pg8::StaticOrder, true, true>(ldsb, g, S, E); SEAM(pb + 3); }
        if (IN(pb + 4)) { LAUNDER_A(); unsigned char* ws = a->ws; unsigned char* wsw = ws + wset_off(l & 1); (void)wsw; bf16* H = (bf16*)(ws + WS_H); bf16* Y = (bf16*)(ws + WS_Y); bf16* U = (bf16*)(ws + WS_U); bf16* Zb = (bf16*)(ws + WS_Z); (void)H; (void)Y; (void)U; (void)Zb; int BX = blockIdx.x; asm volatile("" : "+s"(BX)); int G = gridDim.x; asm volatile("" : "+s"(G)); for (int rep_ = 0; rep_ <= PROBE_DUP_THIN; ++rep_) thinA_phase(a, l); SEAM(pb + 4); }
        if (IN(pb + 5)) { LAUNDER_A(); unsigned char* ws = a->ws; unsigned char* wsw = ws + wset_off(l & 1); (void)wsw; bf16* H = (bf16*)(ws + WS_H); bf16* Y = (bf16*)(ws + WS_Y); bf16* U = (bf16*)(ws + WS_U); bf16* Zb = (bf16*)(ws + WS_Z); (void)H; (void)Y; (void)U; (void)Zb; int BX = blockIdx.x; asm volatile("" : "+s"(BX)); int G = gridDim.x; asm volatile("" : "+s"(G));
            { pg8::Gemm g{(const bf16*)(ws + WS_CQN), (const bf16*)(wsw + WS_WUQ), MT, 768, 768, 768, 0, 0}; pg8::StaticOrder S; S.init(MT, 768, G, (BX + 52) % G);
              pg8::EpiQ E{ws}; for (int rep_ = 0; rep_ <= PROBE_DUP_GEMM; ++rep_) pg8::gemm_phase<pg8::EpiQ, pg8::StaticOrder, true, true>(ldsb, g, S, E); }
            { pg8::Gemm g{(const bf16*)(ws + WS_CKVN), (const bf16*)(wsw + WS_WUKV), MT, 1024, 512, 512, 0, 0}; pg8::StaticOrder S; S.init(MT, 1024, G, (BX + 104) % G);
              pg8::EpiKV E{ws}; for (int rep_ = 0; rep_ <= PROBE_DUP_GEMM; ++rep_) pg8::gemm_phase<pg8::EpiKV, pg8::StaticOrder, true, true>(ldsb, g, S, E); }
            { pg8::Gemm g{(const bf16*)(ws + WS_LIN), (const bf16*)(wsw + WS_WLORA), MT, 1024, 128, 256, 0, 0}; pg8::StaticOrder S; S.init(MT, 1024, G, (BX + 172) % G);
              pg8::EpiLoraW E{a, l, ws}; for (int rep_ = 0; rep_ <= PROBE_DUP_GEMM; ++rep_) pg8::gemm_phase<pg8::EpiLoraW, pg8::StaticOrder, true, true>(ldsb, g, S, E); }
            { pg8::Gemm g{(const bf16*)(ws + WS_LIN), (const bf16*)(wsw + WS_WLORA) + (size_t)1024 * 256, MT, 1024, 128, 256, 0, 0}; pg8::StaticOrder S; S.init(MT, 1024, G, (BX + 156) % G);
              pg8::EpiLoraA E{a, l, ws}; for (int rep_ = 0; rep_ <= PROBE_DUP_GEMM; ++rep_) pg8::gemm_phase<pg8::EpiLoraA, pg8::StaticOrder, true, true>(ldsb, g, S, E); }
            { pg8::Gemm g{(const bf16*)(ws + WS_LIN) + 128, (const bf16*)(wsw + WS_WLORA) + (size_t)2048 * 256 + 128, MT, 512, 128, 256, 0, 0}; pg8::StaticOrder S; S.init(MT, 512, G, (BX + 52) % G);
              pg8::EpiBf16 E{(bf16*)(ws + WS_G), BW, 0}; for (int rep_ = 0; rep_ <= PROBE_DUP_GEMM; ++rep_) pg8::gemm_phase<pg8::EpiBf16, pg8::StaticOrder, true, true>(ldsb, g, S, E); }
            { int K_ = 128; asm volatile("" : "+s"(K_));
              pg8::Gemm g{(const bf16*)(ws + WS_XCVB), (const bf16*)(wsw + WS_WLRU), MT, 2048, K_, 512, (size_t)128 * 2, (size_t)128 * 2}; LruOrder S; S.S.init(MT, 2048, G, (BX + 84) % G);
              pg8::EpiLru E{a, l, ws};
              for (int rep_ = 0; rep_ <= PROBE_DUP_GEMM; ++rep_) pg8::gemm_phase<pg8::EpiLru, LruOrder, true, true>(ldsb, g, S, E); }
            SEAM(pb + 5); }
        if (IN(pb + 6)) { LAUNDER_A(); unsigned char* ws = a->ws; unsigned char* wsw = ws + wset_off(l & 1); (void)wsw; bf16* H = (bf16*)(ws + WS_H); bf16* Y = (bf16*)(ws + WS_Y); bf16* U = (bf16*)(ws + WS_U); bf16* Zb = (bf16*)(ws + WS_Z); (void)H; (void)Y; (void)U; (void)Zb; int BX = blockIdx.x; asm volatile("" : "+s"(BX)); int G = gridDim.x; asm volatile("" : "+s"(G)); mixer_phase(a, l, l, lds, ldsb, MISC);
#if PROBE_DUP_MIXER
            xcd_barrier(bar); mixer_phase(a, l, l + 4, lds, ldsb, MISC);
#endif
#if PROBE_DUP_ATTN
            xcd_barrier(bar); mixer_phase(a, l, l + 4, lds, ldsb, MISC, true);
#endif
            SEAM(pb + 6); }
        if (IN(pb + 7)) { LAUNDER_A(); unsigned char* ws = a->ws; unsigned char* wsw = ws + wset_off(l & 1); int BX = blockIdx.x; asm volatile("" : "+s"(BX)); int G = gridDim.x; asm volatile("" : "+s"(G));
            pg8::Gemm g{(const bf16*)(ws + WS_TG), (const bf16*)(wsw + WS_WGLU), Mpost, 512, 512, 512, 0, 0}; pg8::StaticOrder S; S.init(Mpost, 512, G, BX);
            const int nA = (Mpost / 256) * 2;
            if (BX < nA) { pg8::Unit u0; (void)S.next(0, u0); const int pm0 = __builtin_amdgcn_readfirstlane(u0.pm);
                thinC_rows<true, false>(a, l, pm0 * 256, pm0 * 256 + 256, NWAVES);
                asm volatile("s_waitcnt vmcnt(0)" ::: "memory"); __syncthreads();
                pg8::EpiGlu E{(bf16*)(ws + WS_YS) + (size_t)2 * MT * BW, (const bf16*)(ws + WS_TG), BW, a->in[I_GLUB] + (size_t)l * 512};
                pg8::gemm_phase<pg8::EpiGlu, pg8::StaticOrder, true, true>(ldsb, g, S, E); }
            if (G == 256) { const int ra = 40, rb = lastl ? 88 : 100;
              int lo = BX < nA ? BX * ra : nA * ra + (BX - nA) * rb; int hi = lo + (BX < nA ? ra : rb); if (hi > Mpost) hi = Mpost;
              thinC_rows<false, true>(a, l, lo, hi, NWAVES); }
            else thinC_rows<false, true>(a, l, BX * NWAVES, Mpost, G * NWAVES);
            SEAM(pb + 7); }
        if (IN(pb + 9)) { LAUNDER_A(); unsigned char* ws = a->ws; unsigned char* wsw = ws + wset_off(l & 1); (void)wsw; bf16* H = (bf16*)(ws + WS_H); bf16* Y = (bf16*)(ws + WS_Y); bf16* U = (bf16*)(ws + WS_U); bf16* Zb = (bf16*)(ws + WS_Z); (void)H; (void)Y; (void)U; (void)Zb; int BX = blockIdx.x; asm volatile("" : "+s"(BX)); int G = gridDim.x; asm volatile("" : "+s"(G)); pg8::Gemm g{(const bf16*)(ws + WS_YS), (const bf16*)(wsw + WS_WBR), Mpost, 2048, 512, 512, (size_t)MT * BW * 2, (size_t)2048 * 512 * 2}; pg8::StaticOrder S; S.init(Mpost, 2048, G, BX);
            pg8::EpiGateH E{(const bf16*)(ws + WS_GZ), (bf16*)(ws + WS_MG), DM};
            for (int rep_ = 0; rep_ <= PROBE_DUP_MERGE; ++rep_) pg8::gemm_phase<pg8::EpiGateH, pg8::StaticOrder, true, true, 4, 8>(ldsb, g, S, E); SEAM(pb + 9); }
        if (IN(pb + 10)) { LAUNDER_A(); unsigned char* ws = a->ws; unsigned char* wsw = ws + wset_off(l & 1); (void)wsw; bf16* H = (bf16*)(ws + WS_H); bf16* Y = (bf16*)(ws + WS_Y); bf16* U = (bf16*)(ws + WS_U); bf16* Zb = (bf16*)(ws + WS_Z); (void)H; (void)Y; (void)U; (void)Zb; int BX = blockIdx.x; asm volatile("" : "+s"(BX)); int G = gridDim.x; asm volatile("" : "+s"(G));
            { pg8::Gemm g{(const bf16*)(ws + WS_MG), (const bf16*)(wsw + WS_WOUT), M_LAT, 2048, 2048, 2048, 0, 0}; pg8::StaticOrder S; S.init(M_LAT, 2048, G, BX);
              pg8::EpiBf16 E{Y, DM, 0}; pg8::gemm_phase<pg8::EpiBf16, pg8::StaticOrder, true, true>(ldsb, g, S, E); }
            if (!lastl) { pg8::Gemm g{(const bf16*)(ws + WS_MG) + (size_t)M_LAT * DM, (const bf16*)(wsw + WS_WOUT), M_CTX, 2048, 512, 2048, (size_t)512 * 2, (size_t)512 * 2}; pg8::StaticOrder S; S.init(M_CTX, 2048, G, BX, 4, true);
              pg8::EpiBf16 E{(bf16*)(ws + WS_YP), DM, (size_t)M_CTX * DM}; pg8::gemm_phase<pg8::EpiBf16, pg8::StaticOrder, true, true>(ldsb, g, S, E); }
            SEAM(pb + 10); }
        if (IN(pb + 11)) { LAUNDER_A(); unsigned char* ws = a->ws; unsigned char* wsw = ws + wset_off(l & 1); (void)wsw; bf16* H = (bf16*)(ws + WS_H); bf16* Y = (bf16*)(ws + WS_Y); bf16* U = (bf16*)(ws + WS_U); bf16* Zb = (bf16*)(ws + WS_Z); (void)H; (void)Y; (void)U; (void)Zb; int BX = blockIdx.x; asm volatile("" : "+s"(BX)); int G = gridDim.x; asm volatile("" : "+s"(G)); norm_phase<false, true, true, false>(a, 0, Mpost, l * 3 + 1, 1 + l * 3 + 1); SEAM(pb + 11); }
        if (IN(pb + 12)) { LAUNDER_A(); unsigned char* ws = a->ws; unsigned char* wsw = ws + wset_off(l & 1); (void)wsw; bf16* H = (bf16*)(ws + WS_H); bf16* Y = (bf16*)(ws + WS_Y); bf16* U = (bf16*)(ws + WS_U); bf16* Zb = (bf16*)(ws + WS_Z); (void)H; (void)Y; (void)U; (void)Zb; int BX = blockIdx.x; asm volatile("" : "+s"(BX)); int G = gridDim.x; asm volatile("" : "+s"(G)); pg8::Gemm g{H, (const bf16*)(wsw + WS_W13) + (size_t)11264 * 2048, Mpost, 11264, 2048, 2048, 0, 0}; pg8::StaticOrder S; S.init(Mpost, 11264, G, BX);
            pg8::EpiSwiGLU E{U, DFF}; for (int rep_ = 0; rep_ <= PROBE_DUP_GEMM; ++rep_) pg8::gemm_phase<pg8::EpiSwiGLU, pg8::StaticOrder, true, true>(ldsb, g, S, E); SEAM(pb + 12); }
        if (IN(pb + 13)) { LAUNDER_A(); unsigned char* ws = a->ws; unsigned char* wsw = ws + wset_off(l & 1); (void)wsw; bf16* H = (bf16*)(ws + WS_H); bf16* Y = (bf16*)(ws + WS_Y); bf16* U = (bf16*)(ws + WS_U); bf16* Zb = (bf16*)(ws + WS_Z); (void)H; (void)Y; (void)U; (void)Zb; int BX = blockIdx.x; asm volatile("" : "+s"(BX)); int G = gridDim.x; asm volatile("" : "+s"(G));
            { pg8::Gemm g{U, (const bf16*)(wsw + WS_W2) + (size_t)2048 * 5632, M_LAT, 2048, DFF, DFF, 0, 0}; pg8::StaticOrder S; S.init(M_LAT, 2048, G, BX);
              pg8::EpiBf16 E{Y, DM, 0}; pg8::gemm_phase<pg8::EpiBf16, pg8::StaticOrder, true, true>(ldsb, g, S, E); }
            if (!lastl) { pg8::Gemm g{U + (size_t)M_LAT * DFF, (const bf16*)(wsw + WS_W2) + (size_t)2048 * 5632, M_CTX, 2048, DFF / 4, DFF, (size_t)(DFF / 4) * 2, (size_t)(DFF / 4) * 2}; pg8::StaticOrder S; S.init(M_CTX, 2048, G, BX, 4, true);
              pg8::EpiBf16 E{(bf16*)(ws + WS_YP), DM, (size_t)M_CTX * DM}; pg8::gemm_phase<pg8::EpiBf16, pg8::StaticOrder, true, true>(ldsb, g, S, E); }
            SEAM(pb + 13); }
        if (IN(pb + 14)) { LAUNDER_A(); unsigned char* ws = a->ws; unsigned char* wsw = ws + wset_off(l & 1); (void)wsw; bf16* H = (bf16*)(ws + WS_H); bf16* Y = (bf16*)(ws + WS_Y); bf16* U = (bf16*)(ws + WS_U); bf16* Zb = (bf16*)(ws + WS_Z); (void)H; (void)Y; (void)U; (void)Zb; int BX = blockIdx.x; asm volatile("" : "+s"(BX)); int G = gridDim.x; asm volatile("" : "+s"(G));
            if (!lastl) { norm_phase<false, true, true, false>(a, 0, MT, l * 3 + 2, 1 + l * 3 + 2); }
            else norm_phase<false, true, false, true>(a, 0, M_LAT, l * 3 + 2, 0);
            if (!lastl) SEAM(pb + 14); }
    }
#undef IN
#undef SEAM
}

extern "C" void kernel_launch(void* const* d_in, const int* in_sizes, int n_in, void* d_out, int out_size, void* d_ws, size_t ws_size, hipStream_t stream) {
    static int grid = 0;
    if (grid == 0) {
        if (n_in != N_INPUTS || out_size != M_LAT * DM || ws_size < WS_END) { fprintf(stderr, "kernel_launch: unexpected shapes (n_in %d, out %d, ws %zu < %zu)\n", n_in, out_size, ws_size, (size_t)WS_END); grid = -1; return; }
        int dev = 0, cus = 0;
        if (hipGetDevice(&dev) != hipSuccess || hipDeviceGetAttribute(&cus, hipDeviceAttributeMultiprocessorCount, dev) != hipSuccess) { grid = -1; return; }
        if (hipFuncSetAttribute((const void*)mega_fwd, hipFuncAttributeMaxDynamicSharedMemorySize, LDS_BYTES) != hipSuccess) { fprintf(stderr, "kernel_launch: hipFuncSetAttribute failed\n"); grid = -1; return; }
        int per_cu = 0;
        if (hipOccupancyMaxActiveBlocksPerMultiprocessor(&per_cu, (const void*)mega_fwd, NWAVES * 64, LDS_BYTES) != hipSuccess || per_cu < 1) fprintf(stderr, "kernel_launch: occupancy query reports %d\n", per_cu);
        (void)hipGetLastError();
        if (cus < 256) { fprintf(stderr, "kernel_launch: built for a 256-CU device (the mixer phase deals scan roles to workgroups 0..191); found %d CUs, nothing launched\n", cus); grid = -1; return; }
        grid = cus;
    }
    if (grid < 0) return;
    (void)hipMemsetAsync((char*)d_ws + WS_CTL, 0, CTL_BYTES, stream);
    KArgs a{};
    for (int i = 0; i < N_INPUTS; ++i) a.in[i] = (const float*)d_in[i];
    a.out = (float*)d_out; a.ws = (unsigned char*)d_ws;
#if MK_MULTI
    for (int k = 0; k < NPHASES; ++k) { a.ph_lo = k; a.ph_hi = k + 1; hipLaunchKernelGGL(mega_fwd, dim3(grid), dim3(NWAVES * 64), LDS_BYTES, stream, a); }
#else
    a.ph_lo = 0; a.ph_hi = NPHASES;
    hipLaunchKernelGGL(mega_fwd, dim3(grid), dim3(NWAVES * 64), LDS_BYTES, stream, a);
#endif
}
```
